# Optimizing an MI355X kernel written in HIP

```python
import jax, jax.numpy as jnp
from jax import lax
import numpy as np

D_MODEL = 1024
BATCH = 8
SEQ = 2048
DEPTH = 2
DEC_BATCH = 128
DEC_SEQ = 8
PAST_LEN = 8192
PAGE_SIZE = 128

HEAD_DIM = 64
N_HEADS = 8
N_KV_HEADS = 2
GROUP = N_HEADS // N_KV_HEADS
ATTN_DIM = N_HEADS * HEAD_DIM
KV_DIM = N_KV_HEADS * HEAD_DIM
WINDOW = 128
BLOCK = WINDOW
CONV_DIM = D_MODEL // 2
CONV_WIDTH = 3
D_FF = 4 * D_MODEL
N_BRANCH = 2
IN_DIM = ATTN_DIM + 2 * KV_DIM + 3 * CONV_DIM + N_BRANCH * D_MODEL
CACHE_LEN = min(WINDOW, PAST_LEN)
EPS = 1e-6

kernel_name = "hybrid_swa_sink_shortconv_step"


def rms_norm(x, g):
    xf = x.astype(jnp.float32)
    y = xf * lax.rsqrt(jnp.mean(xf * xf, axis=-1, keepdims=True) + EPS)
    return (y * g.astype(jnp.float32)).astype(x.dtype)


def split_projection(z):
    outs = []
    off = 0
    for width in (ATTN_DIM, KV_DIM, KV_DIM, CONV_DIM, CONV_DIM, CONV_DIM, N_BRANCH * D_MODEL):
        outs.append(z[..., off:off + width])
        off += width
    return outs


def attend(q, k, v, mask, sinks):
    s = jnp.einsum('...qkgd,...skd->...kgqs', q, k).astype(jnp.float32) * (HEAD_DIM ** -0.5)
    s = jnp.where(mask, s, -jnp.inf)
    sink = jnp.broadcast_to(sinks.astype(jnp.float32)[:, :, None, None], s.shape[:-1] + (1,))
    p = jax.nn.softmax(jnp.concatenate([s, sink], axis=-1), axis=-1)[..., :-1]
    return jnp.einsum('...kgqs,...skd->...qkgd', p.astype(v.dtype), v)


def window_attention_prompt(q, k, v, sinks):
    n, s = q.shape[:2]
    nb = s // BLOCK
    qb = q.reshape(n, nb, BLOCK, N_KV_HEADS, GROUP, HEAD_DIM)

    def with_prev(t):
        tb = t.reshape(n, nb, BLOCK, N_KV_HEADS, HEAD_DIM)
        prev = jnp.pad(tb[:, :-1], ((0, 0), (1, 0), (0, 0), (0, 0), (0, 0)))
        return jnp.concatenate([prev, tb], axis=2)

    kk, vv = with_prev(k), with_prev(v)
    rel = jnp.arange(BLOCK)[:, None] + BLOCK - jnp.arange(2 * BLOCK)[None, :]
    band = (rel >= 0) & (rel < WINDOW)
    kpos = (jnp.arange(nb)[:, None] - 1) * BLOCK + jnp.arange(2 * BLOCK)[None, :]
    mask = (band[None] & (kpos >= 0)[:, None, :])[:, None, None]
    o = attend(qb, kk, vv, mask, sinks)
    return o.reshape(n, s, ATTN_DIM)


def window_attention_sample(q, k_new, v_new, k_buf, v_buf, sinks):
    n, t = q.shape[:2]
    l = k_buf.shape[1]
    kk = jnp.concatenate([k_buf, k_new], axis=1)
    vv = jnp.concatenate([v_buf, v_new], axis=1)
    rel = (l + jnp.arange(t))[:, None] - jnp.arange(l + t)[None, :]
    mask = (rel >= 0) & (rel < WINDOW)
    o = attend(q, kk, vv, mask, sinks)
    return o.reshape(n, t, ATTN_DIM), kk[:, t:], vv[:, t:]


def causal_short_conv(u, u_prev, w):
    t = u.shape[1]
    up = jnp.concatenate([u_prev, u], axis=1)
    z = w[0] * up[:, 0:t]
    for i in range(1, CONV_WIDTH):
        z = z + w[i] * up[:, i:i + t]
    return z, up[:, up.shape[1] - (CONV_WIDTH - 1):]


def decoder_layer(x, buf_k, buf_v, buf_conv, g_mix_pre, g_mix_post, g_mlp_pre, g_mlp_post,
                  w_in, attn_sinks, conv_w, w_attn_o, w_conv_o, w_out, w_up, w_down):
    n, t, _ = x.shape
    h = rms_norm(x, g_mix_pre)
    q, k, v, b_gate, c_gate, u_in, gate_logits = split_projection(h @ w_in)
    q = q.reshape(n, t, N_KV_HEADS, GROUP, HEAD_DIM)
    k = k.reshape(n, t, N_KV_HEADS, HEAD_DIM)
    v = v.reshape(n, t, N_KV_HEADS, HEAD_DIM)
    sinks = attn_sinks.reshape(N_KV_HEADS, GROUP)
    u = c_gate * u_in
    if buf_k is None:
        attn = window_attention_prompt(q, k, v, sinks)
        new_k = k[:, t - CACHE_LEN:]
        new_v = v[:, t - CACHE_LEN:]
        conv_prev = jnp.zeros((n, CONV_WIDTH - 1, CONV_DIM), u.dtype)
    else:
        attn, new_k, new_v = window_attention_sample(q, k, v, buf_k, buf_v, sinks)
        conv_prev = buf_conv
    z, new_conv = causal_short_conv(u, conv_prev, conv_w)
    attn_branch = attn @ w_attn_o
    conv_branch = (b_gate * z) @ w_conv_o
    gates = jax.nn.sigmoid(gate_logits).reshape(n, t, N_BRANCH, D_MODEL)
    mixed = (gates[..., 0, :] * attn_branch + gates[..., 1, :] * conv_branch) @ w_out
    x = x + rms_norm(mixed, g_mix_post)
    hm = rms_norm(x, g_mlp_pre)
    ff = jnp.square(jax.nn.relu(hm @ w_up)) @ w_down
    x = x + rms_norm(ff, g_mlp_post)
    return x, new_k, new_v, new_conv


def setup_inputs(seed: int = 0) -> dict:
    key = jax.random.key(seed)
    ks = jax.random.split(key, 20)
    f32 = jnp.float32

    def nrm(k, shape, scale):
        return jax.random.normal(k, shape, f32) * scale

    def gain(k):
        return 1.0 + 0.01 * jax.random.normal(k, (DEPTH, D_MODEL), f32)

    return {
        'x_prompt': nrm(ks[0], (BATCH, SEQ, D_MODEL), 1.0),
        'x_sample': nrm(ks[1], (DEC_BATCH, DEC_SEQ, D_MODEL), 1.0),
        'cache_k': nrm(ks[2], (DEPTH, DEC_BATCH, CACHE_LEN, N_KV_HEADS, HEAD_DIM), 1.0),
        'cache_v': nrm(ks[3], (DEPTH, DEC_BATCH, CACHE_LEN, N_KV_HEADS, HEAD_DIM), 1.0),
        'state_conv': nrm(ks[4], (DEPTH, DEC_BATCH, CONV_WIDTH - 1, CONV_DIM), 1.0),
        'g_mix_pre': gain(ks[5]),
        'g_mix_post': gain(ks[6]),
        'g_mlp_pre': gain(ks[7]),
        'g_mlp_post': gain(ks[8]),
        'w_in': nrm(ks[9], (DEPTH, D_MODEL, IN_DIM), D_MODEL ** -0.5),
        'attn_sinks': nrm(ks[10], (DEPTH, N_HEADS), 0.5),
        'conv_w': nrm(ks[11], (DEPTH, CONV_WIDTH, CONV_DIM), CONV_WIDTH ** -0.5),
        'w_attn_o': nrm(ks[12], (DEPTH, ATTN_DIM, D_MODEL), ATTN_DIM ** -0.5),
        'w_conv_o': nrm(ks[13], (DEPTH, CONV_DIM, D_MODEL), CONV_DIM ** -0.5),
        'w_out': nrm(ks[14], (DEPTH, D_MODEL, D_MODEL), D_MODEL ** -0.5),
        'w_up': nrm(ks[15], (DEPTH, D_MODEL, D_FF), D_MODEL ** -0.5),
        'w_down': nrm(ks[16], (DEPTH, D_FF, D_MODEL), D_FF ** -0.5),
    }


def reference(x_prompt, x_sample, cache_k, cache_v, state_conv, g_mix_pre, g_mix_post,
              g_mlp_pre, g_mlp_post, w_in, attn_sinks, conv_w, w_attn_o, w_conv_o, w_out,
              w_up, w_down):
    yp, ys = x_prompt, x_sample
    kp, vp, cp, kd, vd, cd = [], [], [], [], [], []
    for l in range(DEPTH):
        params = (g_mix_pre[l], g_mix_post[l], g_mlp_pre[l], g_mlp_post[l], w_in[l],
                  attn_sinks[l], conv_w[l], w_attn_o[l], w_conv_o[l], w_out[l], w_up[l], w_down[l])
        yp, nk, nv, nc = decoder_layer(yp, None, None, None, *params)
        kp.append(nk); vp.append(nv); cp.append(nc)
        ys, nk, nv, nc = decoder_layer(ys, cache_k[l], cache_v[l], state_conv[l], *params)
        kd.append(nk); vd.append(nv); cd.append(nc)
    new_k_prompt = jnp.stack(kp)
    new_v_prompt = jnp.stack(vp)
    new_conv_prompt = jnp.stack(cp)
    new_k_sample = jnp.stack(kd)
    new_v_sample = jnp.stack(vd)
    new_conv_sample = jnp.stack(cd)
    return (yp, ys, new_k_prompt, new_v_prompt, new_conv_prompt, new_k_sample, new_v_sample, new_conv_sample)
```

```cpp
#include <hip/hip_runtime.h>
#include <hip/hip_cooperative_groups.h>
#include <cstdio>
#include <cstdint>
namespace cg = cooperative_groups;
namespace pg8 {
#define PG8_LAS __attribute__((address_space(3)))
typedef unsigned short bf16_t;
typedef short bf16x8 __attribute__((ext_vector_type(8)));
typedef float f32x4 __attribute__((ext_vector_type(4)));
typedef unsigned u32x4 __attribute__((ext_vector_type(4)));
constexpr int BM = 256, BK = 64, HALF = 128, HTB = HALF * BK * 2  , STAGE_BYTES = 8 * HTB, NXCD = 8, WGM = 8;

__host__ __device__ __forceinline__ int lds_byte(int r, int c) { const int st = (r >> 4) * 2 + (c >> 5), rr = r & 15, cc = c & 31, ob = rr * 64 + cc * 2; return st * 1024 + (ob ^ (((ob >> 9) & 1) << 5)); }
__host__ __device__ __forceinline__ void stage_rc(int b, int& R, int& C) { const int st = b / 1024, sb = b % 1024, swz = sb ^ (((sb >> 9) & 1) << 5); R = (st >> 1) * 16 + swz / 64; C = (st & 1) * 32 + (swz % 64) / 2; }
__host__ __device__ __forceinline__ int perm32(int rho) { const int n = rho >> 4, i = rho & 15; return 8 * (i >> 2) + 4 * n + (i & 3); }

struct Unit { int pm, pn, pa, pb, w; };
struct Gemm { const bf16_t* A; const bf16_t* Bt; int M, N, K; };

struct StaticOrder {
    int nM, nN, nwg, G, c;
    __host__ __device__ void init(int M, int N, int G_, int c_) { nM = M / BM; nN = N / BM; nwg = nM * nN; G = G_; c = c_; }
    __host__ __device__ bool next(int i, Unit& u) const {
        const long L = (long)i * G + c; if (L >= nwg) return false;
        int wgid = (int)L; { const int q = nwg / NXCD, r = nwg % NXCD, xcd = wgid % NXCD, off = wgid / NXCD; wgid = (xcd < r ? xcd * (q + 1) : r * (q + 1) + (xcd - r) * q) + off; }
        const int nig = WGM * nN, gid = wgid / nig, fm = gid * WGM, gsz = (nM - fm) < WGM ? (nM - fm) : WGM;
        u.pm = fm + ((wgid % nig) % gsz); u.pn = (wgid % nig) / gsz; u.pa = u.pm; u.pb = u.pn; u.w = 0; return true;
    }
    __device__ __forceinline__ void a_ready(const Unit&) const {}
    __device__ __forceinline__ void done(const Unit&) const {}
};
__device__ __forceinline__ unsigned cvt_pk_bf16(float lo, float hi) { unsigned r; asm volatile("v_cvt_pk_bf16_f32 %0, %1, %2" : "=v"(r) : "v"(lo), "v"(hi)); return r; }
template <class Epi, class Sched, bool ALIGN_EPI = false, bool SP2 = false>
__device__ __forceinline__ void gemm_phase(PG8_LAS unsigned char* lds, const Gemm g, const Sched& S, const Epi& E) {
    int tid_ = threadIdx.x; asm volatile("" : "+v"(tid_));
    const int tid = tid_, wid = __builtin_amdgcn_readfirstlane(tid >> 6), lane = tid & 63, wr = wid >> 2, wc = wid & 3, fr = lane & 15, fq = lane >> 4;
    const int K = g.K, nt = K / BK;
    unsigned voffA[2], voffB[2];
#pragma unroll
    for (int i = 0; i < 2; ++i) { int R, C; stage_rc(tid * 16 + i * 8192, R, C); const int Rb = Epi::PERM ? ((R & ~31) + perm32(R & 31)) : R;
        voffA[i] = (unsigned)(R * K + C) * 2u; voffB[i] = (unsigned)(Rb * K + C) * 2u; }
    const size_t kstep = (size_t)(BK * 2);
    const size_t hstep = (size_t)HALF * K * 2;
    const size_t tstep = 2 * hstep;
    const unsigned ldsw = (unsigned)wid * 1024u;
    const int aoff = lds_byte(wr * 64 + fr, fq * 8), boff = lds_byte(wc * 32 + fr, fq * 8);
#define PG8_SA(b, h) (((b) * 2 + (h)) * HTB)
#define PG8_SB(b, h) ((4 + (b) * 2 + (h)) * HTB)
#define PG8_STAGE(bufoff, gbase, voff) do { _Pragma("unroll") for (int _i = 0; _i < 2; ++_i) \
        __builtin_amdgcn_global_load_lds((const unsigned*)((const char*)(gbase) + (voff)[_i]), (PG8_LAS unsigned*)(lds + (bufoff) + ldsw + _i * 8192), 16, 0, 0); } while (0)
#define PG8_LDA(dst, b, h) do { _Pragma("unroll") for (int m = 0; m < 4; ++m) _Pragma("unroll") for (int k = 0; k < 2; ++k) dst[m][k] = *(const PG8_LAS bf16x8*)(lds + PG8_SA(b, h) + aoff + m * 2048 + k * 1024); } while (0)
#define PG8_LDB(dst, b, h) do { _Pragma("unroll") for (int n = 0; n < 2; ++n) _Pragma("unroll") for (int k = 0; k < 2; ++k) dst[n][k] = *(const PG8_LAS bf16x8*)(lds + PG8_SB(b, h) + boff + n * 2048 + k * 1024); } while (0)
#define PG8_MMA(ai, bj, At, Bt) do { __builtin_amdgcn_s_setprio(1); _Pragma("unroll") for (int m = 0; m < 4; ++m) _Pragma("unroll") for (int n = 0; n < 2; ++n) _Pragma("unroll") for (int k = 0; k < 2; ++k) \
        acc[ai][bj][m][n] = __builtin_amdgcn_mfma_f32_16x16x32_bf16(Bt[n][k], At[m][k], acc[ai][bj][m][n], 0, 0, 0); __builtin_amdgcn_s_setprio(0); } while (0)
#define PG8_WAIT_V(n) asm volatile("s_waitcnt vmcnt(" #n ")" ::: "memory")
#define PG8_WAIT_L(n) asm volatile("s_waitcnt lgkmcnt(" #n ")" ::: "memory")
#define PG8_BAR __builtin_amdgcn_s_barrier()
#define PG8_SCHED __builtin_amdgcn_sched_barrier(0)
    Unit cur, nxt; int ui = 0;
    if (!S.next(0, cur)) return;
    f32x4 acc[2][2][4][2];
#pragma unroll
    for (int a = 0; a < 2; ++a)
#pragma unroll
        for (int b = 0; b < 2; ++b)
#pragma unroll
            for (int m = 0; m < 4; ++m)
#pragma unroll
                for (int n = 0; n < 2; ++n) acc[a][b][m][n] = (f32x4){0.f, 0.f, 0.f, 0.f};
    bf16x8 At[4][2], B0[2][2], B1[2][2];
    const char* cA = (const char*)g.A + (size_t)cur.pa * tstep; const char* cB = (const char*)g.Bt + (size_t)cur.pb * tstep;
    S.a_ready(cur);
    if constexpr (SP2) {
        PG8_STAGE(PG8_SB(0, 0), cB, voffB); PG8_STAGE(PG8_SB(0, 1), cB + hstep, voffB); PG8_STAGE(PG8_SA(0, 0), cA, voffA); PG8_STAGE(PG8_SA(0, 1), cA + hstep, voffA);
        if (wr == 1) PG8_BAR;
        PG8_WAIT_V(2); PG8_BAR;
        PG8_STAGE(PG8_SB(1, 0), cB + kstep, voffB); PG8_STAGE(PG8_SA(1, 0), cA + kstep, voffA); PG8_STAGE(PG8_SB(1, 1), cB + hstep + kstep, voffB);
        PG8_WAIT_V(6); PG8_BAR;
    } else {
        PG8_STAGE(PG8_SB(0, 0), cB, voffB); PG8_STAGE(PG8_SA(0, 0), cA, voffA); PG8_STAGE(PG8_SB(0, 1), cB + hstep, voffB); PG8_STAGE(PG8_SA(0, 1), cA + hstep, voffA);
        if (wr == 1) PG8_BAR;
        PG8_WAIT_V(4); PG8_BAR;
        PG8_STAGE(PG8_SB(1, 0), cB + kstep, voffB); PG8_STAGE(PG8_SA(1, 0), cA + kstep, voffA); PG8_STAGE(PG8_SB(1, 1), cB + hstep + kstep, voffB);
        PG8_WAIT_V(6); PG8_BAR;
    }
    for (;;) {
        const bool has_next = S.next(ui + 1, nxt);
        const char* nA = has_next ? (const char*)g.A + (size_t)nxt.pa * tstep : cA; const char* nB = has_next ? (const char*)g.Bt + (size_t)nxt.pb * tstep : cB;
        for (int t = 0; t < nt; t += 2) {
            const bool last = (t == nt - 2);
            const char* a1 = cA + (size_t)(t + 1) * kstep;
            const char* a2 = last ? nA : cA + (size_t)(t + 2) * kstep; const char* b2 = last ? nB : cB + (size_t)(t + 2) * kstep;
            const char* a3 = a2 + kstep; const char* b3 = b2 + kstep;
            if (last && has_next) S.a_ready(nxt);
            if constexpr (SP2) {
            PG8_LDB(B0, 0, 0); PG8_LDB(B1, 0, 1); PG8_SCHED; PG8_LDA(At, 0, 0); PG8_STAGE(PG8_SA(1, 1), a1 + hstep, voffA);
            PG8_WAIT_V(8); PG8_WAIT_L(0); PG8_BAR; PG8_MMA(0, 0, At, B0); PG8_MMA(0, 1, At, B1); PG8_BAR; PG8_SCHED;
            PG8_LDA(At, 0, 1); PG8_STAGE(PG8_SB(0, 0), b2, voffB); PG8_STAGE(PG8_SB(0, 1), b2 + hstep, voffB); PG8_STAGE(PG8_SA(0, 0), a2, voffA);
            PG8_WAIT_V(8); PG8_WAIT_L(0); PG8_BAR; PG8_MMA(1, 0, At, B0); PG8_MMA(1, 1, At, B1); PG8_BAR; PG8_SCHED;
            PG8_LDB(B0, 1, 0); PG8_LDB(B1, 1, 1); PG8_SCHED; PG8_LDA(At, 1, 0); PG8_STAGE(PG8_SA(0, 1), a2 + hstep, voffA);
            PG8_WAIT_V(8); PG8_WAIT_L(0); PG8_BAR; PG8_MMA(0, 0, At, B0); PG8_MMA(0, 1, At, B1); PG8_BAR; PG8_SCHED;
            PG8_LDA(At, 1, 1); PG8_STAGE(PG8_SB(1, 0), b3, voffB); PG8_STAGE(PG8_SB(1, 1), b3 + hstep, voffB); PG8_STAGE(PG8_SA(1, 0), a3, voffA);
            PG8_WAIT_V(8); PG8_WAIT_L(0); PG8_BAR; PG8_MMA(1, 0, At, B0); PG8_MMA(1, 1, At, B1); PG8_BAR; PG8_SCHED;
            } else {
            PG8_LDB(B0, 0, 0); PG8_SCHED; PG8_LDA(At, 0, 0); PG8_STAGE(PG8_SA(1, 1), a1 + hstep, voffA);
            PG8_WAIT_L(8); PG8_BAR; PG8_WAIT_L(0); PG8_MMA(0, 0, At, B0); PG8_BAR; PG8_SCHED;
            PG8_LDB(B1, 0, 1); PG8_STAGE(PG8_SB(0, 0), b2, voffB);
            PG8_BAR; PG8_WAIT_L(0); PG8_MMA(0, 1, At, B1); PG8_BAR;
            PG8_LDA(At, 0, 1); PG8_STAGE(PG8_SA(0, 0), a2, voffA);
            PG8_BAR; PG8_WAIT_L(0); PG8_MMA(1, 0, At, B0); PG8_BAR; PG8_SCHED;
            PG8_STAGE(PG8_SB(0, 1), b2 + hstep, voffB);
            PG8_WAIT_V(6); PG8_BAR; PG8_MMA(1, 1, At, B1); PG8_BAR;
            PG8_LDB(B0, 1, 0); PG8_SCHED; PG8_LDA(At, 1, 0); PG8_STAGE(PG8_SA(0, 1), a2 + hstep, voffA);
            PG8_WAIT_L(8); PG8_BAR; PG8_WAIT_L(0); PG8_MMA(0, 0, At, B0); PG8_BAR; PG8_SCHED;
            PG8_LDB(B1, 1, 1); PG8_STAGE(PG8_SB(1, 0), b3, voffB);
            PG8_BAR; PG8_WAIT_L(0); PG8_MMA(0, 1, At, B1); PG8_BAR;
            PG8_LDA(At, 1, 1); PG8_STAGE(PG8_SA(1, 0), a3, voffA);
            PG8_BAR; PG8_WAIT_L(0); PG8_MMA(1, 0, At, B0); PG8_BAR; PG8_SCHED;
            PG8_STAGE(PG8_SB(1, 1), b3 + hstep, voffB);
            PG8_WAIT_V(6); PG8_BAR; PG8_MMA(1, 1, At, B1); PG8_BAR;
            }
        }
        if constexpr (ALIGN_EPI) { if (wr == 0) PG8_BAR; }
        if constexpr (!Epi::AFTER_DRAIN) { E(acc, cur, wr, wc, fr, fq); S.done(cur); }
        if (!has_next) break;
#pragma unroll
        for (int a = 0; a < 2; ++a)
#pragma unroll
            for (int b = 0; b < 2; ++b)
#pragma unroll
                for (int m = 0; m < 4; ++m)
#pragma unroll
                    for (int n = 0; n < 2; ++n) acc[a][b][m][n] = (f32x4){0.f, 0.f, 0.f, 0.f};
        cur = nxt; cA = nA; cB = nB; ++ui;
        if constexpr (ALIGN_EPI) { if (wr == 1) PG8_BAR; }
    }
    PG8_WAIT_V(0);
    if constexpr (!ALIGN_EPI) { if (wr == 0) PG8_BAR; }
    PG8_BAR;
    if constexpr (Epi::AFTER_DRAIN) { E.fused(acc, cur, wr, wc, fr, fq, lds, wid, lane); S.done(cur); }
#undef PG8_SA
#undef PG8_SB
#undef PG8_STAGE
#undef PG8_LDA
#undef PG8_LDB
#undef PG8_MMA
#undef PG8_WAIT_V
#undef PG8_WAIT_L
#undef PG8_BAR
#undef PG8_SCHED
}
}
#define LAS __attribute__((address_space(3)))
typedef unsigned short bf16_t;
typedef short bf16x8 __attribute__((ext_vector_type(8)));
typedef float f32x4 __attribute__((ext_vector_type(4)));
typedef unsigned u32x4 __attribute__((ext_vector_type(4)));
typedef unsigned u32x2 __attribute__((ext_vector_type(2)));

constexpr int DM = 1024, NBATCH = 8, SEQ = 2048, DEPTH = 2, DBATCH = 128, DSEQ = 8;
constexpr int MP = NBATCH * SEQ, MS = DBATCH * DSEQ, M = MP + MS;
constexpr int IN_DIM = 4352, ATT = 512, CD = 512, FF = 4096;
constexpr int ZP = IN_DIM;
constexpr int ZQ = 0, ZK = 512, ZV = 640, ZB = 768, ZC = 1280, ZU = 1792, ZGA = 2304;
constexpr float EPS = 1e-6f;
constexpr float LOG2E = 1.4426950408889634f;

constexpr size_t O_Y = 0;
constexpr size_t O_KP = (size_t)M * DM;
constexpr size_t O_VP = O_KP + 2 * 8 * 128 * 128;
constexpr size_t O_CP = O_VP + 2 * 8 * 128 * 128;
constexpr size_t O_KS = O_CP + 2 * 8 * 2 * 512;
constexpr size_t O_VS = O_KS + (size_t)2 * 128 * 128 * 128;
constexpr size_t O_CS = O_VS + (size_t)2 * 128 * 128 * 128;

constexpr size_t MiB = 1u << 20;
constexpr size_t WS_R = 0;
constexpr size_t WS_W = 1 * MiB;
constexpr size_t W_IN = 0, W_BR = W_IN + (size_t)IN_DIM * DM, W_OUT = W_BR + (size_t)2048 * 512, W_UP = W_OUT + (size_t)DM * DM, W_DN = W_UP + (size_t)FF * DM, W_END = W_DN + (size_t)DM * FF;
constexpr size_t WS_Z = 30 * MiB;
constexpr size_t WS_S1 = 175 * MiB;
constexpr size_t WS_S2 = 209 * MiB;
constexpr size_t WS_END = 243 * MiB;
static_assert(WS_W + W_END * 2 <= WS_Z && WS_Z + (size_t)M * ZP * 2 <= WS_S1 && WS_S1 + (size_t)M * DM * 2 <= WS_S2 && WS_S2 + (size_t)M * DM * 2 <= WS_END, "ws map");

constexpr int LDS_BYTES = 147456;
constexpr int NTHREADS = 512, NWAVES = 8;

__device__ __forceinline__ float bf2f(unsigned b) { return __uint_as_float(b << 16); }
__device__ __forceinline__ unsigned pk2(float lo, float hi) { return pg8::cvt_pk_bf16(lo, hi); }
__device__ __forceinline__ float wave_sum(float v) {
#pragma unroll
    for (int o = 1; o < 64; o <<= 1) v += __shfl_xor(v, o);
    return v;
}
__device__ __forceinline__ void unpack8(const u32x4 v, float (&f)[8]) {
    f[0] = bf2f(v.x & 0xffffu); f[1] = __uint_as_float(v.x & 0xffff0000u); f[2] = bf2f(v.y & 0xffffu); f[3] = __uint_as_float(v.y & 0xffff0000u);
    f[4] = bf2f(v.z & 0xffffu); f[5] = __uint_as_float(v.z & 0xffff0000u); f[6] = bf2f(v.w & 0xffffu); f[7] = __uint_as_float(v.w & 0xffff0000u);
}
__device__ __forceinline__ u32x4 pack8(const float (&f)[8]) { u32x4 w; w.x = pk2(f[0], f[1]); w.y = pk2(f[2], f[3]); w.z = pk2(f[4], f[5]); w.w = pk2(f[6], f[7]); return w; }
__device__ __forceinline__ float sigmoidf_fast(float x) { return __builtin_amdgcn_rcpf(1.0f + __builtin_amdgcn_exp2f(-x * LOG2E)); }

template <int MODE> struct Epi {
    static constexpr bool PERM = true, AFTER_DRAIN = false;
    bf16_t* O; int ldc; const float* r; const bf16_t* Z;
    __device__ __forceinline__ void operator()(const f32x4 (&acc)[2][2][4][2], const pg8::Unit& u, int wr, int wc, int fr, int fq) const {
        const int row0 = u.pm * 256 + wr * 64 + fr, col0 = u.pn * 256 + wc * 32 + 8 * fq;
#pragma unroll
        for (int ai = 0; ai < 2; ++ai)
#pragma unroll
            for (int m = 0; m < 4; ++m) {
                const int row = row0 + ai * 128 + m * 16;
                float rs = 1.f;
                if (MODE == 1 || MODE == 6) rs = r[row];
#pragma unroll
                for (int bj = 0; bj < 2; ++bj) {
                    const int col = col0 + bj * 128;
                    const f32x4 a0 = acc[ai][bj][m][0], a1 = acc[ai][bj][m][1];
                    float v[8] = {a0[0], a0[1], a0[2], a0[3], a1[0], a1[1], a1[2], a1[3]};
                    bf16_t* dst = O + (size_t)row * ldc + col;
                    if (MODE == 1) {
#pragma unroll
                        for (int e = 0; e < 8; ++e) v[e] *= rs;
                        if (u.pn >= 9) {
#pragma unroll
                            for (int e = 0; e < 8; ++e) v[e] = sigmoidf_fast(v[e]);
                        }
                    } else if (MODE == 3) {
                        float gt[8]; unpack8(*(const u32x4*)(Z + (size_t)row * ZP + ZGA + u.w * 1024 + col), gt);
#pragma unroll
                        for (int e = 0; e < 8; ++e) v[e] *= gt[e];
                        if (u.w == 1) { float t[8]; unpack8(*(const u32x4*)dst, t);
#pragma unroll
                            for (int e = 0; e < 8; ++e) v[e] += t[e]; }
                    } else if (MODE == 6) {
#pragma unroll
                        for (int e = 0; e < 8; ++e) { const float q = fmaxf(v[e] * rs, 0.f); v[e] = q * q; }
                    }
                    *(u32x4*)dst = pack8(v);
                }
            }
    }
};

struct PairOrder {
    pg8::StaticOrder so; int nMt;
    __device__ void init(int M_, int N_, int G_, int c_) { so.init(M_, N_, G_, c_); nMt = M_ / 256; }
    __device__ bool next(int i, pg8::Unit& u) const { if (!so.next(i >> 1, u)) return false; u.w = i & 1; u.pa = u.w * nMt + u.pm; u.pb = u.w * so.nN + u.pn; return true; }
    __device__ __forceinline__ void a_ready(const pg8::Unit&) const {}
    __device__ __forceinline__ void done(const pg8::Unit&) const {}
};

__device__ __forceinline__ void transpose_item(const float* W, const float* gk, int K, int N, bf16_t* WT, int row_off, LAS float* scr, int item, int lane) {
    const int nblk = N / 32, kb = item / nblk, nb = item % nblk, k0 = 64 * kb, n0 = 32 * nb;
#pragma unroll 8
    for (int i = 0; i < 32; ++i) { const int kk = 2 * i + (lane >> 5); float w = W[(size_t)(k0 + kk) * N + n0 + (lane & 31)]; if (gk) w *= gk[k0 + kk]; scr[kk * 33 + (lane & 31)] = w; }
    asm volatile("s_waitcnt lgkmcnt(0)" ::: "memory");
    const int c = lane & 7;
#pragma unroll
    for (int j = 0; j < 4; ++j) { const int n = (lane >> 3) + 8 * j; const LAS float* s = scr + (8 * c) * 33 + n;
        u32x4 o; o.x = pk2(s[0 * 33], s[1 * 33]); o.y = pk2(s[2 * 33], s[3 * 33]); o.z = pk2(s[4 * 33], s[5 * 33]); o.w = pk2(s[6 * 33], s[7 * 33]);
        *(u32x4*)(WT + (size_t)(row_off + n0 + n) * K + k0 + 8 * c) = o; }
    asm volatile("s_waitcnt lgkmcnt(0)" ::: "memory");
}
struct Args { const float* in[17]; float* out; unsigned char* ws; };

__device__ __forceinline__ void convert_weights(const Args& a, int l, bf16_t* Wb, LAS unsigned char* lds, int gw, int NGW, int wave, int lane) {
    LAS float* scr = (LAS float*)(lds + wave * 16384);
    constexpr int I_IN = 16 * 136, I_AO = 8 * 32, I_CO = 8 * 32, I_OUT = 16 * 32, I_UP = 16 * 128, I_DN = 64 * 32;
    constexpr int NITEMS = I_IN + I_AO + I_CO + I_OUT + I_UP + I_DN;
    const float* w_in = a.in[9] + (size_t)l * DM * IN_DIM; const float* w_ao = a.in[12] + (size_t)l * ATT * DM; const float* w_co = a.in[13] + (size_t)l * CD * DM;
    const float* w_out = a.in[14] + (size_t)l * DM * DM; const float* w_up = a.in[15] + (size_t)l * DM * FF; const float* w_dn = a.in[16] + (size_t)l * FF * DM;
    const float* g_pre = a.in[5] + l * DM; const float* g_mlp = a.in[7] + l * DM;
    for (int it = gw; it < NITEMS; it += NGW) {
        int r = it;
        if (r < I_IN) { transpose_item(w_in, g_pre, DM, IN_DIM, Wb + W_IN, 0, scr, r, lane); continue; } r -= I_IN;
        if (r < I_AO) { transpose_item(w_ao, nullptr, ATT, DM, Wb + W_BR, 0, scr, r, lane); continue; } r -= I_AO;
        if (r < I_CO) { transpose_item(w_co, nullptr, CD, DM, Wb + W_BR, 1024, scr, r, lane); continue; } r -= I_CO;
        if (r < I_OUT) { transpose_item(w_out, nullptr, DM, DM, Wb + W_OUT, 0, scr, r, lane); continue; } r -= I_OUT;
        if (r < I_UP) { transpose_item(w_up, g_mlp, DM, FF, Wb + W_UP, 0, scr, r, lane); continue; } r -= I_UP;
        transpose_item(w_dn, nullptr, FF, DM, Wb + W_DN, 0, scr, r, lane);
    }
}

__device__ __forceinline__ void rows_prologue(const float* xp, const float* xs, bf16_t* xb, float* r, int gw, int NGW, int lane) {
    for (int row = gw; row < M; row += NGW) {
        const float* xr = (row < MP) ? xp + (size_t)row * DM : xs + (size_t)(row - MP) * DM;
        f32x4 v[4]; float ss = 0.f;
#pragma unroll
        for (int j = 0; j < 4; ++j) { v[j] = *(const f32x4*)(xr + 4 * lane + 256 * j); ss += (v[j][0] * v[j][0] + v[j][1] * v[j][1]) + (v[j][2] * v[j][2] + v[j][3] * v[j][3]); }
        ss = wave_sum(ss);
#pragma unroll
        for (int j = 0; j < 4; ++j) { u32x2 w; w.x = pk2(v[j][0], v[j][1]); w.y = pk2(v[j][2], v[j][3]); *(u32x2*)(xb + (size_t)row * DM + 4 * lane + 256 * j) = w; }
        if (lane == 0) r[row] = 1.0f / sqrtf(ss * (1.0f / DM) + EPS);
    }
}
__device__ __forceinline__ void rows_residual(const bf16_t* src, const float* xin_p, const float* xin_s, const float* g, float* xout, bf16_t* xb, float* r, int gw, int NGW, int lane) {
    f32x4 gv[4];
#pragma unroll
    for (int j = 0; j < 4; ++j) gv[j] = *(const f32x4*)(g + 4 * lane + 256 * j);
    for (int row = gw; row < M; row += NGW) {
        const float* xr = (row < MP) ? xin_p + (size_t)row * DM : xin_s + (size_t)(row - MP) * DM;
        f32x4 s[4], x[4]; float ss = 0.f;
#pragma unroll
        for (int j = 0; j < 4; ++j) { const u32x2 w = *(const u32x2*)(src + (size_t)row * DM + 4 * lane + 256 * j); x[j] = *(const f32x4*)(xr + 4 * lane + 256 * j);
            s[j][0] = bf2f(w.x & 0xffffu); s[j][1] = __uint_as_float(w.x & 0xffff0000u); s[j][2] = bf2f(w.y & 0xffffu); s[j][3] = __uint_as_float(w.y & 0xffff0000u);
            ss += (s[j][0] * s[j][0] + s[j][1] * s[j][1]) + (s[j][2] * s[j][2] + s[j][3] * s[j][3]); }
        ss = wave_sum(ss);
        const float rm = 1.0f / sqrtf(ss * (1.0f / DM) + EPS);
        float s2 = 0.f;
#pragma unroll
        for (int j = 0; j < 4; ++j) { x[j] = x[j] + s[j] * rm * gv[j]; s2 += (x[j][0] * x[j][0] + x[j][1] * x[j][1]) + (x[j][2] * x[j][2] + x[j][3] * x[j][3]); }
        s2 = wave_sum(s2);
#pragma unroll
        for (int j = 0; j < 4; ++j) { *(f32x4*)(xout + (size_t)row * DM + 4 * lane + 256 * j) = x[j];
            u32x2 w; w.x = pk2(x[j][0], x[j][1]); w.y = pk2(x[j][2], x[j][3]); *(u32x2*)(xb + (size_t)row * DM + 4 * lane + 256 * j) = w; }
        if (lane == 0) r[row] = 1.0f / sqrtf(s2 * (1.0f / DM) + EPS);
    }
}

constexpr int KS_STRIDE = 72, VT_STRIDE = 264;
constexpr int VT_OFF = 256 * KS_STRIDE * 2;
constexpr float SC_L2 = 0.125f * LOG2E;

template <bool SAMPLE>
__device__ __forceinline__ void attn_qtile(const LAS unsigned char* lds, const bf16_t* Z, bf16_t* AO, int qrow, int head, int iq, int tb, bool has_prev, float sink_l2, int lane) {
    const int q = lane & 15, g = lane >> 4;
    const bf16x8 qf0 = *(const bf16x8*)(Z + (size_t)qrow * ZP + ZQ + head * 64 + 8 * g);
    const bf16x8 qf1 = *(const bf16x8*)(Z + (size_t)qrow * ZP + ZQ + head * 64 + 32 + 8 * g);
    f32x4 s[10];
    const LAS unsigned char* kbase = lds + ((tb * 16 + q) * KS_STRIDE + 8 * g) * 2;
#pragma unroll
    for (int t = 0; t < 10; ++t) {
        const bf16x8 a0 = *(const LAS bf16x8*)(kbase + t * 16 * KS_STRIDE * 2);
        const bf16x8 a1 = *(const LAS bf16x8*)(kbase + t * 16 * KS_STRIDE * 2 + 64);
        f32x4 z = {0.f, 0.f, 0.f, 0.f};
        z = __builtin_amdgcn_mfma_f32_16x16x32_bf16(a0, qf0, z, 0, 0, 0);
        z = __builtin_amdgcn_mfma_f32_16x16x32_bf16(a1, qf1, z, 0, 0, 0);
        s[t] = z;
    }
    float mx = sink_l2;
#pragma unroll
    for (int t = 0; t < 10; ++t)
#pragma unroll
        for (int j = 0; j < 4; ++j) {
            const int kk = (tb + t) * 16 + 4 * g + j;
            bool vis = (kk > iq) && (kk <= iq + 128);
            if (!SAMPLE) vis = vis && (has_prev || kk >= 128);
            const float v = vis ? s[t][j] * SC_L2 : -INFINITY;
            s[t][j] = v; mx = fmaxf(mx, v);
        }
    mx = fmaxf(mx, __shfl_xor(mx, 16)); mx = fmaxf(mx, __shfl_xor(mx, 32));
    float sum = 0.f;
#pragma unroll
    for (int t = 0; t < 10; ++t)
#pragma unroll
        for (int j = 0; j < 4; ++j) { const float p = __builtin_amdgcn_exp2f(s[t][j] - mx); s[t][j] = p; sum += p; }
    sum += __shfl_xor(sum, 16); sum += __shfl_xor(sum, 32);
    sum += __builtin_amdgcn_exp2f(sink_l2 - mx);
    const float inv = 1.0f / sum;
    bf16x8 pf[5];
#pragma unroll
    for (int c = 0; c < 5; ++c) {
        u32x4 w; w.x = pk2(s[2 * c][0] * inv, s[2 * c][1] * inv); w.y = pk2(s[2 * c][2] * inv, s[2 * c][3] * inv);
        w.z = pk2(s[2 * c + 1][0] * inv, s[2 * c + 1][1] * inv); w.w = pk2(s[2 * c + 1][2] * inv, s[2 * c + 1][3] * inv);
        pf[c] = __builtin_bit_cast(bf16x8, w);
    }
    f32x4 o[4];
#pragma unroll
    for (int dt = 0; dt < 4; ++dt) o[dt] = (f32x4){0.f, 0.f, 0.f, 0.f};
    const LAS unsigned char* vbase = lds + VT_OFF + (q * VT_STRIDE + tb * 16 + 4 * g) * 2;
#pragma unroll
    for (int c = 0; c < 5; ++c)
#pragma unroll
        for (int dt = 0; dt < 4; ++dt) {
            const u32x2 lo = *(const LAS u32x2*)(vbase + dt * 16 * VT_STRIDE * 2 + c * 64);
            const u32x2 hi = *(const LAS u32x2*)(vbase + dt * 16 * VT_STRIDE * 2 + c * 64 + 32);
            const u32x4 av = {lo.x, lo.y, hi.x, hi.y};
            o[dt] = __builtin_amdgcn_mfma_f32_16x16x32_bf16(__builtin_bit_cast(bf16x8, av), pf[c], o[dt], 0, 0, 0);
        }
#pragma unroll
    for (int dt = 0; dt < 4; ++dt) { u32x2 w; w.x = pk2(o[dt][0], o[dt][1]); w.y = pk2(o[dt][2], o[dt][3]);
        *(u32x2*)(AO + (size_t)qrow * ATT + head * 64 + dt * 16 + 4 * g) = w; }
}

__device__ __forceinline__ void lds_put_kv(LAS unsigned char* lds, int key, int ch, u32x4 kv, u32x4 vv) {
    *(LAS u32x4*)(lds + key * (KS_STRIDE * 2) + ch * 16) = kv;
    LAS unsigned short* vt = (LAS unsigned short*)(lds + VT_OFF) + (ch * 8) * VT_STRIDE + key;
    vt[0 * VT_STRIDE] = (unsigned short)(vv.x & 0xffffu); vt[1 * VT_STRIDE] = (unsigned short)(vv.x >> 16);
    vt[2 * VT_STRIDE] = (unsigned short)(vv.y & 0xffffu); vt[3 * VT_STRIDE] = (unsigned short)(vv.y >> 16);
    vt[4 * VT_STRIDE] = (unsigned short)(vv.z & 0xffffu); vt[5 * VT_STRIDE] = (unsigned short)(vv.z >> 16);
    vt[6 * VT_STRIDE] = (unsigned short)(vv.w & 0xffffu); vt[7 * VT_STRIDE] = (unsigned short)(vv.w >> 16);
}
__device__ __forceinline__ void store8f(float* dst, const u32x4 v) { float f[8]; unpack8(v, f); *(f32x4*)dst = (f32x4){f[0], f[1], f[2], f[3]}; *(f32x4*)(dst + 4) = (f32x4){f[4], f[5], f[6], f[7]}; }

__device__ __forceinline__ void attn_prompt_unit(const Args& a, int l, int unit, const bf16_t* Z, bf16_t* AO, LAS unsigned char* lds, int tid, int wave, int lane) {
    const int b = unit >> 5, qb = (unit >> 1) & 15, kvh = unit & 1;
    const int rowbase = b * SEQ + qb * 128;
    const bool has_prev = qb > 0;
#pragma unroll
    for (int i = 0; i < 4; ++i) {
        const int item = tid + NTHREADS * i, key = item >> 3, ch = item & 7;
        u32x4 kv = {0u, 0u, 0u, 0u}, vv = {0u, 0u, 0u, 0u};
        if (has_prev || key >= 128) {
            const bf16_t* zr = Z + (size_t)(rowbase - 128 + key) * ZP + kvh * 64 + ch * 8;
            kv = *(const u32x4*)(zr + ZK); vv = *(const u32x4*)(zr + ZV);
            if (qb == 15 && key >= 128) {
                const size_t o = (((size_t)(l * NBATCH + b) * 128 + (key - 128)) * 2 + kvh) * 64 + ch * 8;
                store8f(a.out + O_KP + o, kv); store8f(a.out + O_VP + o, vv);
            }
        }
        lds_put_kv(lds, key, ch, kv, vv);
    }
    __syncthreads();
    const int hh = wave >> 1, half = wave & 1, head = kvh * 4 + hh;
    const float sink_l2 = a.in[10][l * 8 + head] * LOG2E;
#pragma unroll 1
    for (int qt = 0; qt < 4; ++qt) {
        const int iq0 = half * 64 + qt * 16, iq = iq0 + (lane & 15);
        attn_qtile<false>(lds, Z, AO, rowbase + iq, head, iq, (iq0 >> 4) & ~1, has_prev, sink_l2, lane);
    }
    __syncthreads();
}
__device__ __forceinline__ void attn_sample_unit(const Args& a, int l, int unit, const bf16_t* Z, bf16_t* AO, LAS unsigned char* lds, int tid, int wave, int lane) {
    const int n = unit >> 1, kvh = unit & 1;
    const float* ck = a.in[2] + ((size_t)(l * DBATCH + n) * 128) * 128 + kvh * 64;
    const float* cv = a.in[3] + ((size_t)(l * DBATCH + n) * 128) * 128 + kvh * 64;
#pragma unroll
    for (int i = 0; i < 3; ++i) {
        const int item = tid + NTHREADS * i, key = item >> 3, ch = item & 7;
        if (item < 160 * 8) {
            u32x4 kv = {0u, 0u, 0u, 0u}, vv = {0u, 0u, 0u, 0u};
            const size_t o = (((size_t)(l * DBATCH + n) * 128 + (key - 8)) * 2 + kvh) * 64 + ch * 8;
            if (key < 128) {
                const f32x4 k0 = *(const f32x4*)(ck + (size_t)key * 128 + ch * 8), k1 = *(const f32x4*)(ck + (size_t)key * 128 + ch * 8 + 4);
                const f32x4 v0 = *(const f32x4*)(cv + (size_t)key * 128 + ch * 8), v1 = *(const f32x4*)(cv + (size_t)key * 128 + ch * 8 + 4);
                kv = (u32x4){pk2(k0[0], k0[1]), pk2(k0[2], k0[3]), pk2(k1[0], k1[1]), pk2(k1[2], k1[3])};
                vv = (u32x4){pk2(v0[0], v0[1]), pk2(v0[2], v0[3]), pk2(v1[0], v1[1]), pk2(v1[2], v1[3])};
                if (key >= 8) { *(f32x4*)(a.out + O_KS + o) = k0; *(f32x4*)(a.out + O_KS + o + 4) = k1; *(f32x4*)(a.out + O_VS + o) = v0; *(f32x4*)(a.out + O_VS + o + 4) = v1; }
            } else if (key < 136) {
                const bf16_t* zr = Z + (size_t)(MP + n * DSEQ + (key - 128)) * ZP + kvh * 64 + ch * 8;
                kv = *(const u32x4*)(zr + ZK); vv = *(const u32x4*)(zr + ZV);
                store8f(a.out + O_KS + o, kv); store8f(a.out + O_VS + o, vv);
            }
            lds_put_kv(lds, key, ch, kv, vv);
        }
    }
    __syncthreads();
    if (wave < 2) {
        const int q = lane & 15, head = kvh * 4 + wave * 2 + (q >> 3), t = q & 7;
        const float sink_l2 = a.in[10][l * 8 + head] * LOG2E;
        attn_qtile<true>(lds, Z, AO, MP + n * DSEQ + t, head, t, 0, true, sink_l2, lane);
    }
    __syncthreads();
}

__device__ __forceinline__ void conv_phase(const Args& a, int l, const bf16_t* Z, bf16_t* BZ, int gtid, int nth) {
    const float* cw = a.in[11] + (size_t)l * 3 * CD;
    for (int item = gtid; item < M * 64; item += nth) {
        const int row = item >> 6, c0 = (item & 63) * 8;
        const bool smp = row >= MP;
        const int t = smp ? ((row - MP) & 7) : (row & (SEQ - 1));
        const int n = smp ? ((row - MP) >> 3) : (row >> 11);
        const bf16_t* zr = Z + (size_t)row * ZP + c0;
        float Bv[8], Cv[8], Uv[8], u2[8], u1[8], u0[8];
        unpack8(*(const u32x4*)(zr + ZB), Bv); unpack8(*(const u32x4*)(zr + ZC), Cv); unpack8(*(const u32x4*)(zr + ZU), Uv);
#pragma unroll
        for (int e = 0; e < 8; ++e) u2[e] = Cv[e] * Uv[e];
        if (t >= 1) { unpack8(*(const u32x4*)(zr - ZP + ZC), Cv); unpack8(*(const u32x4*)(zr - ZP + ZU), Uv);
#pragma unroll
            for (int e = 0; e < 8; ++e) u1[e] = Cv[e] * Uv[e];
        } else if (smp) { const float* sp = a.in[4] + ((size_t)(l * DBATCH + n) * 2 + 1) * CD + c0;
#pragma unroll
            for (int e = 0; e < 8; ++e) u1[e] = sp[e];
        } else {
#pragma unroll
            for (int e = 0; e < 8; ++e) u1[e] = 0.f;
        }
        if (t >= 2) { unpack8(*(const u32x4*)(zr - 2 * ZP + ZC), Cv); unpack8(*(const u32x4*)(zr - 2 * ZP + ZU), Uv);
#pragma unroll
            for (int e = 0; e < 8; ++e) u0[e] = Cv[e] * Uv[e];
        } else if (smp) { const float* sp = a.in[4] + ((size_t)(l * DBATCH + n) * 2 + t) * CD + c0;
#pragma unroll
            for (int e = 0; e < 8; ++e) u0[e] = sp[e];
        } else {
#pragma unroll
            for (int e = 0; e < 8; ++e) u0[e] = 0.f;
        }
        float o[8];
#pragma unroll
        for (int e = 0; e < 8; ++e) o[e] = Bv[e] * (cw[c0 + e] * u0[e] + cw[CD + c0 + e] * u1[e] + cw[2 * CD + c0 + e] * u2[e]);
        *(u32x4*)(BZ + (size_t)row * CD + c0) = pack8(o);
        const int tl = smp ? DSEQ : SEQ;
        if (t >= tl - 2) {
            float* dst = smp ? a.out + O_CS + ((size_t)(l * DBATCH + n) * 2 + (t - (tl - 2))) * CD + c0 : a.out + O_CP + ((size_t)(l * NBATCH + n) * 2 + (t - (tl - 2))) * CD + c0;
            *(f32x4*)dst = (f32x4){u2[0], u2[1], u2[2], u2[3]}; *(f32x4*)(dst + 4) = (f32x4){u2[4], u2[5], u2[6], u2[7]};
        }
    }
}

__global__ void __launch_bounds__(NTHREADS, 2) fwd_megakernel(Args a) {
    extern __shared__ __attribute__((aligned(16))) unsigned char lds_raw[];
    LAS unsigned char* lds = (LAS unsigned char*)lds_raw;
    cg::grid_group grid = cg::this_grid();
    const int G = gridDim.x, bx = blockIdx.x, NGW = G * NWAVES;
#define FRESH() int tid = threadIdx.x; asm volatile("" : "+v"(tid)); const int lane = tid & 63, wave = __builtin_amdgcn_readfirstlane(tid >> 6), gw = bx * NWAVES + wave; (void)lane; (void)gw
    unsigned char* ws = a.ws;
    float* R = (float*)(ws + WS_R);
    bf16_t* Wb = (bf16_t*)(ws + WS_W);
    bf16_t* Z = (bf16_t*)(ws + WS_Z);
    bf16_t* S1 = (bf16_t*)(ws + WS_S1);
    bf16_t* S2 = (bf16_t*)(ws + WS_S2);
    float* Y = a.out + O_Y;

    { FRESH(); convert_weights(a, 0, Wb, lds, gw, NGW, wave, lane);
      rows_prologue(a.in[0], a.in[1], S2, R, gw, NGW, lane); }
    grid.sync();

#pragma unroll 1
    for (int l = 0; l < DEPTH; ++l) {
#ifndef PHM
#define PHM 0xff
#endif
        if (PHM & 1) {
            pg8::Gemm g{S2, Wb + W_IN, M, IN_DIM, DM}; pg8::StaticOrder S; S.init(M, IN_DIM, G, bx);
            Epi<1> E{Z, ZP, R, Z};
            pg8::gemm_phase<Epi<1>, pg8::StaticOrder, true, true>(lds, g, S, E);
        }
        grid.sync();
        if (PHM & 2) {
            FRESH();
            for (int u = bx; u < NBATCH * 16 * 2; u += G) attn_prompt_unit(a, l, u, Z, S1, lds, tid, wave, lane);
            for (int u = bx; u < DBATCH * 2; u += G) attn_sample_unit(a, l, u, Z, S1, lds, tid, wave, lane);
            conv_phase(a, l, Z, S1 + (size_t)M * ATT, bx * NTHREADS + tid, G * NTHREADS);
        }
        grid.sync();
        if (PHM & 4) {
            pg8::Gemm g{S1, Wb + W_BR, 2 * M, 2048, 512}; PairOrder S; S.init(M, DM, G, bx);
            Epi<3> E{S2, DM, R, Z};
            pg8::gemm_phase<Epi<3>, PairOrder, true, true>(lds, g, S, E);
        }
        grid.sync();
        if (PHM & 8) {
            pg8::Gemm g{S2, Wb + W_OUT, M, DM, DM}; pg8::StaticOrder S; S.init(M, DM, G, bx);
            Epi<4> E{S1, DM, R, Z};
            pg8::gemm_phase<Epi<4>, pg8::StaticOrder, true, true>(lds, g, S, E);
        }
        grid.sync();
        { FRESH(); rows_residual(S1, l == 0 ? a.in[0] : Y, l == 0 ? a.in[1] : Y + (size_t)MP * DM, a.in[6] + l * DM, Y, S2, R, gw, NGW, lane); }
        grid.sync();
        if (PHM & 16) {
            pg8::Gemm g{S2, Wb + W_UP, M, FF, DM}; pg8::StaticOrder S; S.init(M, FF, G, bx);
            Epi<6> E{Z, FF, R, Z};
            pg8::gemm_phase<Epi<6>, pg8::StaticOrder, true, true>(lds, g, S, E);
        }
        grid.sync();
        if (PHM & 32) {
            pg8::Gemm g{Z, Wb + W_DN, M, DM, FF}; pg8::StaticOrder S; S.init(M, DM, G, bx);
            Epi<4> E{S1, DM, R, Z};
            pg8::gemm_phase<Epi<4>, pg8::StaticOrder, true, true>(lds, g, S, E);
        }
        grid.sync();
        { FRESH(); rows_residual(S1, Y, Y + (size_t)MP * DM, a.in[8] + l * DM, Y, S2, R, gw, NGW, lane);
          if (l + 1 < DEPTH) convert_weights(a, l + 1, Wb, lds, gw, NGW, wave, lane); }
        if (l + 1 < DEPTH) grid.sync();
    }
}

extern "C" void kernel_launch(void* const* d_in, const int* in_sizes, int n_in, void* d_out, int out_size, void* d_ws, size_t ws_size, hipStream_t stream) {
    static int grid = 0;
    if (grid == 0) {
        if (n_in != 17 || ws_size < WS_END) { fprintf(stderr, "kernel_launch: unexpected n_in %d / ws_size %zu (need %zu)\n", n_in, ws_size, (size_t)WS_END); grid = -1; return; }
        int dev = 0, cus = 0, per_cu = 0;
        hipGetDevice(&dev);
        hipDeviceGetAttribute(&cus, hipDeviceAttributeMultiprocessorCount, dev);
        if (hipFuncSetAttribute((const void*)fwd_megakernel, hipFuncAttributeMaxDynamicSharedMemorySize, LDS_BYTES) != hipSuccess) fprintf(stderr, "kernel_launch: hipFuncSetAttribute failed\n");
        if (hipOccupancyMaxActiveBlocksPerMultiprocessor(&per_cu, (const void*)fwd_megakernel, NTHREADS, LDS_BYTES) != hipSuccess || per_cu < 1) { fprintf(stderr, "kernel_launch: occupancy query gave %d\n", per_cu); per_cu = 1; }
        (void)hipGetLastError();
        grid = cus * per_cu;
    }
    if (grid < 0) return;
    Args a{};
    for (int i = 0; i < 17; ++i) a.in[i] = (const float*)d_in[i];
    a.out = (float*)d_out; a.ws = (unsigned char*)d_ws;
    void* args[] = {&a};
    hipError_t e = hipLaunchCooperativeKernel((const void*)fwd_megakernel, dim3(grid), dim3(NTHREADS), args, LDS_BYTES, stream);
    if (e != hipSuccess) fprintf(stderr, "cooperative launch failed: %s (grid %d)\n", hipGetErrorString(e), grid);
}
```

```cpp
#include <hip/hip_runtime.h>
#include <hip/hip_cooperative_groups.h>
#include <cstdio>
#include <cstdint>
namespace cg = cooperative_groups;
namespace pg8 {
#define PG8_LAS __attribute__((address_space(3)))
typedef unsigned short bf16_t;
typedef short bf16x8 __attribute__((ext_vector_type(8)));
typedef float f32x4 __attribute__((ext_vector_type(4)));
typedef unsigned u32x4 __attribute__((ext_vector_type(4)));
constexpr int BM = 256, BK = 64, HALF = 128, HTB = HALF * BK * 2  , STAGE_BYTES = 8 * HTB, NXCD = 8, WGM = 8;

__host__ __device__ __forceinline__ int lds_byte(int r, int c) { const int st = (r >> 4) * 2 + (c >> 5), rr = r & 15, cc = c & 31, ob = rr * 64 + cc * 2; return st * 1024 + (ob ^ (((ob >> 9) & 1) << 5)); }
__host__ __device__ __forceinline__ void stage_rc(int b, int& R, int& C) { const int st = b / 1024, sb = b % 1024, swz = sb ^ (((sb >> 9) & 1) << 5); R = (st >> 1) * 16 + swz / 64; C = (st & 1) * 32 + (swz % 64) / 2; }
__host__ __device__ __forceinline__ int perm32(int rho) { const int n = rho >> 4, i = rho & 15; return 8 * (i >> 2) + 4 * n + (i & 3); }

struct Unit { int pm, pn, pa, pb, w; };
struct Gemm { const bf16_t* A; const bf16_t* Bt; int M, N, K; };

struct StaticOrder {
    int nM, nN, nwg, G, c;
    __host__ __device__ void init(int M, int N, int G_, int c_) { nM = M / BM; nN = N / BM; nwg = nM * nN; G = G_; c = c_; }
    __host__ __device__ bool next(int i, Unit& u) const {
        const long L = (long)i * G + c; if (L >= nwg) return false;
        int wgid = (int)L; { const int q = nwg / NXCD, r = nwg % NXCD, xcd = wgid % NXCD, off = wgid / NXCD; wgid = (xcd < r ? xcd * (q + 1) : r * (q + 1) + (xcd - r) * q) + off; }
        const int nig = WGM * nN, gid = wgid / nig, fm = gid * WGM, gsz = (nM - fm) < WGM ? (nM - fm) : WGM;
        u.pm = fm + ((wgid % nig) % gsz); u.pn = (wgid % nig) / gsz; u.pa = u.pm; u.pb = u.pn; u.w = 0; return true;
    }
    __device__ __forceinline__ void a_ready(const Unit&) const {}
    __device__ __forceinline__ void done(const Unit&) const {}
};
__device__ __forceinline__ unsigned cvt_pk_bf16(float lo, float hi) { unsigned r; asm volatile("v_cvt_pk_bf16_f32 %0, %1, %2" : "=v"(r) : "v"(lo), "v"(hi)); return r; }
template <class Epi, class Sched, bool ALIGN_EPI = false, bool SP2 = false>
__device__ __forceinline__ void gemm_phase(PG8_LAS unsigned char* lds, const Gemm g, const Sched& S, const Epi& E) {
    int tid_ = threadIdx.x; asm volatile("" : "+v"(tid_));
    const int tid = tid_, wid = __builtin_amdgcn_readfirstlane(tid >> 6), lane = tid & 63, wr = wid >> 2, wc = wid & 3, fr = lane & 15, fq = lane >> 4;
    const int K = g.K, nt = K / BK;
    unsigned voffA[2], voffB[2];
#pragma unroll
    for (int i = 0; i < 2; ++i) { int R, C; stage_rc(tid * 16 + i * 8192, R, C); const int Rb = Epi::PERM ? ((R & ~31) + perm32(R & 31)) : R;
        voffA[i] = (unsigned)(R * K + C) * 2u; voffB[i] = (unsigned)(Rb * K + C) * 2u; }
    const size_t kstep = (size_t)(BK * 2);
    const size_t hstep = (size_t)HALF * K * 2;
    const size_t tstep = 2 * hstep;
    const unsigned ldsw = (unsigned)wid * 1024u;
    const int aoff = lds_byte(wr * 64 + fr, fq * 8), boff = lds_byte(wc * 32 + fr, fq * 8);
#define PG8_SA(b, h) (((b) * 2 + (h)) * HTB)
#define PG8_SB(b, h) ((4 + (b) * 2 + (h)) * HTB)
#define PG8_STAGE(bufoff, gbase, voff) do { _Pragma("unroll") for (int _i = 0; _i < 2; ++_i) \
        __builtin_amdgcn_global_load_lds((const unsigned*)((const char*)(gbase) + (voff)[_i]), (PG8_LAS unsigned*)(lds + (bufoff) + ldsw + _i * 8192), 16, 0, 0); } while (0)
#define PG8_LDA(dst, b, h) do { _Pragma("unroll") for (int m = 0; m < 4; ++m) _Pragma("unroll") for (int k = 0; k < 2; ++k) dst[m][k] = *(const PG8_LAS bf16x8*)(lds + PG8_SA(b, h) + aoff + m * 2048 + k * 1024); } while (0)
#define PG8_LDB(dst, b, h) do { _Pragma("unroll") for (int n = 0; n < 2; ++n) _Pragma("unroll") for (int k = 0; k < 2; ++k) dst[n][k] = *(const PG8_LAS bf16x8*)(lds + PG8_SB(b, h) + boff + n * 2048 + k * 1024); } while (0)
#define PG8_MMA(ai, bj, At, Bt) do { __builtin_amdgcn_s_setprio(1); _Pragma("unroll") for (int m = 0; m < 4; ++m) _Pragma("unroll") for (int n = 0; n < 2; ++n) _Pragma("unroll") for (int k = 0; k < 2; ++k) \
        acc[ai][bj][m][n] = __builtin_amdgcn_mfma_f32_16x16x32_bf16(Bt[n][k], At[m][k], acc[ai][bj][m][n], 0, 0, 0); __builtin_amdgcn_s_setprio(0); } while (0)
#define PG8_WAIT_V(n) asm volatile("s_waitcnt vmcnt(" #n ")" ::: "memory")
#define PG8_WAIT_L(n) asm volatile("s_waitcnt lgkmcnt(" #n ")" ::: "memory")
#define PG8_BAR __builtin_amdgcn_s_barrier()
#define PG8_SCHED __builtin_amdgcn_sched_barrier(0)
    Unit cur, nxt; int ui = 0;
    if (!S.next(0, cur)) return;
    f32x4 acc[2][2][4][2];
#pragma unroll
    for (int a = 0; a < 2; ++a)
#pragma unroll
        for (int b = 0; b < 2; ++b)
#pragma unroll
            for (int m = 0; m < 4; ++m)
#pragma unroll
                for (int n = 0; n < 2; ++n) acc[a][b][m][n] = (f32x4){0.f, 0.f, 0.f, 0.f};
    bf16x8 At[4][2], B0[2][2], B1[2][2];
    const char* cA = (const char*)g.A + (size_t)cur.pa * tstep; const char* cB = (const char*)g.Bt + (size_t)cur.pb * tstep;
    S.a_ready(cur);
    if constexpr (SP2) {
        PG8_STAGE(PG8_SB(0, 0), cB, voffB); PG8_STAGE(PG8_SB(0, 1), cB + hstep, voffB); PG8_STAGE(PG8_SA(0, 0), cA, voffA); PG8_STAGE(PG8_SA(0, 1), cA + hstep, voffA);
        if (wr == 1) PG8_BAR;
        PG8_WAIT_V(2); PG8_BAR;
        PG8_STAGE(PG8_SB(1, 0), cB + kstep, voffB); PG8_STAGE(PG8_SA(1, 0), cA + kstep, voffA); PG8_STAGE(PG8_SB(1, 1), cB + hstep + kstep, voffB);
        PG8_WAIT_V(6); PG8_BAR;
    } else {
        PG8_STAGE(PG8_SB(0, 0), cB, voffB); PG8_STAGE(PG8_SA(0, 0), cA, voffA); PG8_STAGE(PG8_SB(0, 1), cB + hstep, voffB); PG8_STAGE(PG8_SA(0, 1), cA + hstep, voffA);
        if (wr == 1) PG8_BAR;
        PG8_WAIT_V(4); PG8_BAR;
        PG8_STAGE(PG8_SB(1, 0), cB + kstep, voffB); PG8_STAGE(PG8_SA(1, 0), cA + kstep, voffA); PG8_STAGE(PG8_SB(1, 1), cB + hstep + kstep, voffB);
        PG8_WAIT_V(6); PG8_BAR;
    }
    for (;;) {
        const bool has_next = S.next(ui + 1, nxt);
        const char* nA = has_next ? (const char*)g.A + (size_t)nxt.pa * tstep : cA; const char* nB = has_next ? (const char*)g.Bt + (size_t)nxt.pb * tstep : cB;
        for (int t = 0; t < nt; t += 2) {
            const bool last = (t == nt - 2);
            const char* a1 = cA + (size_t)(t + 1) * kstep;
            const char* a2 = last ? nA : cA + (size_t)(t + 2) * kstep; const char* b2 = last ? nB : cB + (size_t)(t + 2) * kstep;
            const char* a3 = a2 + kstep; const char* b3 = b2 + kstep;
            if (last && has_next) S.a_ready(nxt);
            if constexpr (SP2) {
            PG8_LDB(B0, 0, 0); PG8_LDB(B1, 0, 1); PG8_SCHED; PG8_LDA(At, 0, 0); PG8_STAGE(PG8_SA(1, 1), a1 + hstep, voffA);
            PG8_WAIT_V(8); PG8_WAIT_L(0); PG8_BAR; PG8_MMA(0, 0, At, B0); PG8_MMA(0, 1, At, B1); PG8_BAR; PG8_SCHED;
            PG8_LDA(At, 0, 1); PG8_STAGE(PG8_SB(0, 0), b2, voffB); PG8_STAGE(PG8_SB(0, 1), b2 + hstep, voffB); PG8_STAGE(PG8_SA(0, 0), a2, voffA);
            PG8_WAIT_V(8); PG8_WAIT_L(0); PG8_BAR; PG8_MMA(1, 0, At, B0); PG8_MMA(1, 1, At, B1); PG8_BAR; PG8_SCHED;
            PG8_LDB(B0, 1, 0); PG8_LDB(B1, 1, 1); PG8_SCHED; PG8_LDA(At, 1, 0); PG8_STAGE(PG8_SA(0, 1), a2 + hstep, voffA);
            PG8_WAIT_V(8); PG8_WAIT_L(0); PG8_BAR; PG8_MMA(0, 0, At, B0); PG8_MMA(0, 1, At, B1); PG8_BAR; PG8_SCHED;
            PG8_LDA(At, 1, 1); PG8_STAGE(PG8_SB(1, 0), b3, voffB); PG8_STAGE(PG8_SB(1, 1), b3 + hstep, voffB); PG8_STAGE(PG8_SA(1, 0), a3, voffA);
            PG8_WAIT_V(8); PG8_WAIT_L(0); PG8_BAR; PG8_MMA(1, 0, At, B0); PG8_MMA(1, 1, At, B1); PG8_BAR; PG8_SCHED;
            } else {
            PG8_LDB(B0, 0, 0); PG8_SCHED; PG8_LDA(At, 0, 0); PG8_STAGE(PG8_SA(1, 1), a1 + hstep, voffA);
            PG8_WAIT_L(8); PG8_BAR; PG8_WAIT_L(0); PG8_MMA(0, 0, At, B0); PG8_BAR; PG8_SCHED;
            PG8_LDB(B1, 0, 1); PG8_STAGE(PG8_SB(0, 0), b2, voffB);
            PG8_BAR; PG8_WAIT_L(0); PG8_MMA(0, 1, At, B1); PG8_BAR;
            PG8_LDA(At, 0, 1); PG8_STAGE(PG8_SA(0, 0), a2, voffA);
            PG8_BAR; PG8_WAIT_L(0); PG8_MMA(1, 0, At, B0); PG8_BAR; PG8_SCHED;
            PG8_STAGE(PG8_SB(0, 1), b2 + hstep, voffB);
            PG8_WAIT_V(6); PG8_BAR; PG8_MMA(1, 1, At, B1); PG8_BAR;
            PG8_LDB(B0, 1, 0); PG8_SCHED; PG8_LDA(At, 1, 0); PG8_STAGE(PG8_SA(0, 1), a2 + hstep, voffA);
            PG8_WAIT_L(8); PG8_BAR; PG8_WAIT_L(0); PG8_MMA(0, 0, At, B0); PG8_BAR; PG8_SCHED;
            PG8_LDB(B1, 1, 1); PG8_STAGE(PG8_SB(1, 0), b3, voffB);
            PG8_BAR; PG8_WAIT_L(0); PG8_MMA(0, 1, At, B1); PG8_BAR;
            PG8_LDA(At, 1, 1); PG8_STAGE(PG8_SA(1, 0), a3, voffA);
            PG8_BAR; PG8_WAIT_L(0); PG8_MMA(1, 0, At, B0); PG8_BAR; PG8_SCHED;
            PG8_STAGE(PG8_SB(1, 1), b3 + hstep, voffB);
            PG8_WAIT_V(6); PG8_BAR; PG8_MMA(1, 1, At, B1); PG8_BAR;
            }
        }
        if constexpr (ALIGN_EPI) { if (wr == 0) PG8_BAR; }
        if constexpr (!Epi::AFTER_DRAIN) { E(acc, cur, wr, wc, fr, fq); S.done(cur); }
        if (!has_next) break;
#pragma unroll
        for (int a = 0; a < 2; ++a)
#pragma unroll
            for (int b = 0; b < 2; ++b)
#pragma unroll
                for (int m = 0; m < 4; ++m)
#pragma unroll
                    for (int n = 0; n < 2; ++n) acc[a][b][m][n] = (f32x4){0.f, 0.f, 0.f, 0.f};
        cur = nxt; cA = nA; cB = nB; ++ui;
        if constexpr (ALIGN_EPI) { if (wr == 1) PG8_BAR; }
    }
    PG8_WAIT_V(0);
    if constexpr (!ALIGN_EPI) { if (wr == 0) PG8_BAR; }
    PG8_BAR;
    if constexpr (Epi::AFTER_DRAIN) { E.fused(acc, cur, wr, wc, fr, fq, lds, wid, lane); S.done(cur); }
#undef PG8_SA
#undef PG8_SB
#undef PG8_STAGE
#undef PG8_LDA
#undef PG8_LDB
#undef PG8_MMA
#undef PG8_WAIT_V
#undef PG8_WAIT_L
#undef PG8_BAR
#undef PG8_SCHED
}
}
#define LAS __attribute__((address_space(3)))
typedef unsigned short bf16_t;
typedef short bf16x8 __attribute__((ext_vector_type(8)));
typedef float f32x4 __attribute__((ext_vector_type(4)));
typedef unsigned u32x4 __attribute__((ext_vector_type(4)));
typedef unsigned u32x2 __attribute__((ext_vector_type(2)));

constexpr int DM = 1024, NBATCH = 8, SEQ = 2048, DEPTH = 2, DBATCH = 128, DSEQ = 8;
constexpr int MP = NBATCH * SEQ, MS = DBATCH * DSEQ, M = MP + MS;
constexpr int IN_DIM = 4352, ATT = 512, CD = 512, FF = 4096;
constexpr int ZP = IN_DIM;
constexpr int ZQ = 0, ZK = 512, ZV = 640, ZB = 768, ZC = 1280, ZU = 1792, ZGA = 2304;
constexpr float EPS = 1e-6f;
constexpr float LOG2E = 1.4426950408889634f;

constexpr size_t O_Y = 0;
constexpr size_t O_KP = (size_t)M * DM;
constexpr size_t O_VP = O_KP + 2 * 8 * 128 * 128;
constexpr size_t O_CP = O_VP + 2 * 8 * 128 * 128;
constexpr size_t O_KS = O_CP + 2 * 8 * 2 * 512;
constexpr size_t O_VS = O_KS + (size_t)2 * 128 * 128 * 128;
constexpr size_t O_CS = O_VS + (size_t)2 * 128 * 128 * 128;

constexpr size_t MiB = 1u << 20;
constexpr size_t WS_R = 0;
constexpr size_t WS_BAR = 512 * 1024;
constexpr size_t WS_W = 1 * MiB;
constexpr size_t W_IN = 0, W_BR = W_IN + (size_t)IN_DIM * DM, W_OUT = W_BR + (size_t)2048 * 512, W_UP = W_OUT + (size_t)DM * DM, W_DN = W_UP + (size_t)FF * DM, W_END = W_DN + (size_t)DM * FF;
constexpr size_t WS_Z = 30 * MiB;
constexpr size_t WS_S1 = 175 * MiB;
constexpr size_t WS_S2 = 209 * MiB;
constexpr size_t WS_END = 243 * MiB;
static_assert(WS_W + W_END * 2 <= WS_Z && WS_Z + (size_t)M * ZP * 2 <= WS_S1 && WS_S1 + (size_t)M * DM * 2 <= WS_S2 && WS_S2 + (size_t)M * DM * 2 <= WS_END, "ws map");

constexpr int LDS_BYTES = 147456;
constexpr int NTHREADS = 512, NWAVES = 8;

__device__ __forceinline__ float bf2f(unsigned b) { return __uint_as_float(b << 16); }
__device__ __forceinline__ unsigned pk2(float lo, float hi) { return pg8::cvt_pk_bf16(lo, hi); }
__device__ __forceinline__ float wave_sum(float v) {
#pragma unroll
    for (int o = 1; o < 64; o <<= 1) v += __shfl_xor(v, o);
    return v;
}
__device__ __forceinline__ void unpack8(const u32x4 v, float (&f)[8]) {
    f[0] = bf2f(v.x & 0xffffu); f[1] = __uint_as_float(v.x & 0xffff0000u); f[2] = bf2f(v.y & 0xffffu); f[3] = __uint_as_float(v.y & 0xffff0000u);
    f[4] = bf2f(v.z & 0xffffu); f[5] = __uint_as_float(v.z & 0xffff0000u); f[6] = bf2f(v.w & 0xffffu); f[7] = __uint_as_float(v.w & 0xffff0000u);
}
__device__ __forceinline__ u32x4 pack8(const float (&f)[8]) { u32x4 w; w.x = pk2(f[0], f[1]); w.y = pk2(f[2], f[3]); w.z = pk2(f[4], f[5]); w.w = pk2(f[6], f[7]); return w; }
__device__ __forceinline__ float sigmoidf_fast(float x) { return __builtin_amdgcn_rcpf(1.0f + __builtin_amdgcn_exp2f(-x * LOG2E)); }

template <int MODE> struct Epi {
    static constexpr bool PERM = true, AFTER_DRAIN = false;
    bf16_t* O; int ldc; const float* r; const bf16_t* Z;
    __device__ __forceinline__ void operator()(const f32x4 (&acc)[2][2][4][2], const pg8::Unit& u, int wr, int wc, int fr, int fq) const {
        const int row0 = u.pm * 256 + wr * 64 + fr, col0 = u.pn * 256 + wc * 32 + 8 * fq;
#pragma unroll
        for (int ai = 0; ai < 2; ++ai)
#pragma unroll
            for (int m = 0; m < 4; ++m) {
                const int row = row0 + ai * 128 + m * 16;
                float rs = 1.f;
                if (MODE == 1 || MODE == 6) rs = r[row];
#pragma unroll
                for (int bj = 0; bj < 2; ++bj) {
                    const int col = col0 + bj * 128;
                    const f32x4 a0 = acc[ai][bj][m][0], a1 = acc[ai][bj][m][1];
                    float v[8] = {a0[0], a0[1], a0[2], a0[3], a1[0], a1[1], a1[2], a1[3]};
                    bf16_t* dst = O + (size_t)row * ldc + col;
                    if (MODE == 1) {
#pragma unroll
                        for (int e = 0; e < 8; ++e) v[e] *= rs;
                        if (u.pn >= 9) {
#pragma unroll
                            for (int e = 0; e < 8; ++e) v[e] = sigmoidf_fast(v[e]);
                        }
                    } else if (MODE == 3) {
                        float gt[8]; unpack8(*(const u32x4*)(Z + (size_t)row * ZP + ZGA + u.w * 1024 + col), gt);
#pragma unroll
                        for (int e = 0; e < 8; ++e) v[e] *= gt[e];
                        if (u.w == 1) { float t[8]; unpack8(*(const u32x4*)dst, t);
#pragma unroll
                            for (int e = 0; e < 8; ++e) v[e] += t[e]; }
                    } else if (MODE == 6) {
#pragma unroll
                        for (int e = 0; e < 8; ++e) { const float q = fmaxf(v[e] * rs, 0.f); v[e] = q * q; }
                    }
                    *(u32x4*)dst = pack8(v);
                }
            }
    }
};

struct PairOrder {
    pg8::StaticOrder so; int nMt;
    __device__ void init(int M_, int N_, int G_, int c_) { so.init(M_, N_, G_, c_); nMt = M_ / 256; }
    __device__ bool next(int i, pg8::Unit& u) const { if (!so.next(i >> 1, u)) return false; u.w = i & 1; u.pa = u.w * nMt + u.pm; u.pb = u.w * so.nN + u.pn; return true; }
    __device__ __forceinline__ void a_ready(const pg8::Unit&) const {}
    __device__ __forceinline__ void done(const pg8::Unit&) const {}
};

__device__ __forceinline__ void transpose_item(const float* W, const float* gk, int K, int N, bf16_t* WT, int row_off, LAS float* scr, int item, int lane) {
    const int nblk = N / 32, kb = item / nblk, nb = item % nblk, k0 = 64 * kb, n0 = 32 * nb;
#pragma unroll 8
    for (int i = 0; i < 32; ++i) { const int kk = 2 * i + (lane >> 5); float w = W[(size_t)(k0 + kk) * N + n0 + (lane & 31)]; if (gk) w *= gk[k0 + kk]; scr[kk * 33 + (lane & 31)] = w; }
    asm volatile("s_waitcnt lgkmcnt(0)" ::: "memory");
    const int c = lane & 7;
#pragma unroll
    for (int j = 0; j < 4; ++j) { const int n = (lane >> 3) + 8 * j; const LAS float* s = scr + (8 * c) * 33 + n;
        u32x4 o; o.x = pk2(s[0 * 33], s[1 * 33]); o.y = pk2(s[2 * 33], s[3 * 33]); o.z = pk2(s[4 * 33], s[5 * 33]); o.w = pk2(s[6 * 33], s[7 * 33]);
        *(u32x4*)(WT + (size_t)(row_off + n0 + n) * K + k0 + 8 * c) = o; }
    asm volatile("s_waitcnt lgkmcnt(0)" ::: "memory");
}
struct Args { const float* in[17]; float* out; unsigned char* ws; };

__device__ __forceinline__ void convert_weights(const Args& a, int l, bf16_t* Wb, LAS unsigned char* lds, int gw, int NGW, int wave, int lane) {
    LAS float* scr = (LAS float*)(lds + wave * 16384);
    constexpr int I_IN = 16 * 136, I_AO = 8 * 32, I_CO = 8 * 32, I_OUT = 16 * 32, I_UP = 16 * 128, I_DN = 64 * 32;
    constexpr int NITEMS = I_IN + I_AO + I_CO + I_OUT + I_UP + I_DN;
    const float* w_in = a.in[9] + (size_t)l * DM * IN_DIM; const float* w_ao = a.in[12] + (size_t)l * ATT * DM; const float* w_co = a.in[13] + (size_t)l * CD * DM;
    const float* w_out = a.in[14] + (size_t)l * DM * DM; const float* w_up = a.in[15] + (size_t)l * DM * FF; const float* w_dn = a.in[16] + (size_t)l * FF * DM;
    const float* g_pre = a.in[5] + l * DM; const float* g_mlp = a.in[7] + l * DM;
    for (int it = gw; it < NITEMS; it += NGW) {
        int r = it;
        if (r < I_IN) { transpose_item(w_in, g_pre, DM, IN_DIM, Wb + W_IN, 0, scr, r, lane); continue; } r -= I_IN;
        if (r < I_AO) { transpose_item(w_ao, nullptr, ATT, DM, Wb + W_BR, 0, scr, r, lane); continue; } r -= I_AO;
        if (r < I_CO) { transpose_item(w_co, nullptr, CD, DM, Wb + W_BR, 1024, scr, r, lane); continue; } r -= I_CO;
        if (r < I_OUT) { transpose_item(w_out, nullptr, DM, DM, Wb + W_OUT, 0, scr, r, lane); continue; } r -= I_OUT;
        if (r < I_UP) { transpose_item(w_up, g_mlp, DM, FF, Wb + W_UP, 0, scr, r, lane); continue; } r -= I_UP;
        transpose_item(w_dn, nullptr, FF, DM, Wb + W_DN, 0, scr, r, lane);
    }
}

__device__ __forceinline__ void rows_prologue(const float* xp, const float* xs, bf16_t* xb, float* r, int gw, int NGW, int lane) {
    for (int row = gw; row < M; row += NGW) {
        const float* xr = (row < MP) ? xp + (size_t)row * DM : xs + (size_t)(row - MP) * DM;
        f32x4 v[4]; float ss = 0.f;
#pragma unroll
        for (int j = 0; j < 4; ++j) { v[j] = *(const f32x4*)(xr + 4 * lane + 256 * j); ss += (v[j][0] * v[j][0] + v[j][1] * v[j][1]) + (v[j][2] * v[j][2] + v[j][3] * v[j][3]); }
        ss = wave_sum(ss);
#pragma unroll
        for (int j = 0; j < 4; ++j) { u32x2 w; w.x = pk2(v[j][0], v[j][1]); w.y = pk2(v[j][2], v[j][3]); *(u32x2*)(xb + (size_t)row * DM + 4 * lane + 256 * j) = w; }
        if (lane == 0) r[row] = 1.0f / sqrtf(ss * (1.0f / DM) + EPS);
    }
}
__device__ __forceinline__ void rows_residual(const bf16_t* src, const float* xin_p, const float* xin_s, const float* g, float* xout, bf16_t* xb, float* r, int gw, int NGW, int lane) {
    f32x4 gv[4];
#pragma unroll
    for (int j = 0; j < 4; ++j) gv[j] = *(const f32x4*)(g + 4 * lane + 256 * j);
    for (int row = gw; row < M; row += NGW) {
        const float* xr = (row < MP) ? xin_p + (size_t)row * DM : xin_s + (size_t)(row - MP) * DM;
        f32x4 s[4], x[4]; float ss = 0.f;
#pragma unroll
        for (int j = 0; j < 4; ++j) { const u32x2 w = *(const u32x2*)(src + (size_t)row * DM + 4 * lane + 256 * j); x[j] = *(const f32x4*)(xr + 4 * lane + 256 * j);
            s[j][0] = bf2f(w.x & 0xffffu); s[j][1] = __uint_as_float(w.x & 0xffff0000u); s[j][2] = bf2f(w.y & 0xffffu); s[j][3] = __uint_as_float(w.y & 0xffff0000u);
            ss += (s[j][0] * s[j][0] + s[j][1] * s[j][1]) + (s[j][2] * s[j][2] + s[j][3] * s[j][3]); }
        ss = wave_sum(ss);
        const float rm = 1.0f / sqrtf(ss * (1.0f / DM) + EPS);
        float s2 = 0.f;
#pragma unroll
        for (int j = 0; j < 4; ++j) { x[j] = x[j] + s[j] * rm * gv[j]; s2 += (x[j][0] * x[j][0] + x[j][1] * x[j][1]) + (x[j][2] * x[j][2] + x[j][3] * x[j][3]); }
        s2 = wave_sum(s2);
#pragma unroll
        for (int j = 0; j < 4; ++j) { *(f32x4*)(xout + (size_t)row * DM + 4 * lane + 256 * j) = x[j];
            u32x2 w; w.x = pk2(x[j][0], x[j][1]); w.y = pk2(x[j][2], x[j][3]); *(u32x2*)(xb + (size_t)row * DM + 4 * lane + 256 * j) = w; }
        if (lane == 0) r[row] = 1.0f / sqrtf(s2 * (1.0f / DM) + EPS);
    }
}

constexpr int KS_STRIDE = 72, VT_STRIDE = 264;
constexpr int VT_OFF = 256 * KS_STRIDE * 2;
constexpr float SC_L2 = 0.125f * LOG2E;

template <bool SAMPLE>
__device__ __forceinline__ void attn_qtile(const LAS unsigned char* lds, const bf16_t* Z, bf16_t* AO, int qrow, int head, int iq, int tb, bool has_prev, float sink_l2, int lane) {
    const int q = lane & 15, g = lane >> 4;
    const bf16x8 qf0 = *(const bf16x8*)(Z + (size_t)qrow * ZP + ZQ + head * 64 + 8 * g);
    const bf16x8 qf1 = *(const bf16x8*)(Z + (size_t)qrow * ZP + ZQ + head * 64 + 32 + 8 * g);
    f32x4 s[10];
    const LAS unsigned char* kbase = lds + ((tb * 16 + q) * KS_STRIDE + 8 * g) * 2;
#pragma unroll
    for (int t = 0; t < 10; ++t) {
        const bf16x8 a0 = *(const LAS bf16x8*)(kbase + t * 16 * KS_STRIDE * 2);
        const bf16x8 a1 = *(const LAS bf16x8*)(kbase + t * 16 * KS_STRIDE * 2 + 64);
        f32x4 z = {0.f, 0.f, 0.f, 0.f};
        z = __builtin_amdgcn_mfma_f32_16x16x32_bf16(a0, qf0, z, 0, 0, 0);
        z = __builtin_amdgcn_mfma_f32_16x16x32_bf16(a1, qf1, z, 0, 0, 0);
        s[t] = z;
    }
    float mx = sink_l2;
#pragma unroll
    for (int t = 0; t < 10; ++t)
#pragma unroll
        for (int j = 0; j < 4; ++j) {
            const int kk = (tb + t) * 16 + 4 * g + j;
            bool vis = (kk > iq) && (kk <= iq + 128);
            if (!SAMPLE) vis = vis && (has_prev || kk >= 128);
            const float v = vis ? s[t][j] * SC_L2 : -INFINITY;
            s[t][j] = v; mx = fmaxf(mx, v);
        }
    mx = fmaxf(mx, __shfl_xor(mx, 16)); mx = fmaxf(mx, __shfl_xor(mx, 32));
    float sum = 0.f;
#pragma unroll
    for (int t = 0; t < 10; ++t)
#pragma unroll
        for (int j = 0; j < 4; ++j) { const float p = __builtin_amdgcn_exp2f(s[t][j] - mx); s[t][j] = p; sum += p; }
    sum += __shfl_xor(sum, 16); sum += __shfl_xor(sum, 32);
    sum += __builtin_amdgcn_exp2f(sink_l2 - mx);
    const float inv = 1.0f / sum;
    bf16x8 pf[5];
#pragma unroll
    for (int c = 0; c < 5; ++c) {
        u32x4 w; w.x = pk2(s[2 * c][0] * inv, s[2 * c][1] * inv); w.y = pk2(s[2 * c][2] * inv, s[2 * c][3] * inv);
        w.z = pk2(s[2 * c + 1][0] * inv, s[2 * c + 1][1] * inv); w.w = pk2(s[2 * c + 1][2] * inv, s[2 * c + 1][3] * inv);
        pf[c] = __builtin_bit_cast(bf16x8, w);
    }
    f32x4 o[4];
#pragma unroll
    for (int dt = 0; dt < 4; ++dt) o[dt] = (f32x4){0.f, 0.f, 0.f, 0.f};
    const LAS unsigned char* vbase = lds + VT_OFF + (q * VT_STRIDE + tb * 16 + 4 * g) * 2;
#pragma unroll
    for (int c = 0; c < 5; ++c)
#pragma unroll
        for (int dt = 0; dt < 4; ++dt) {
            const u32x2 lo = *(const LAS u32x2*)(vbase + dt * 16 * VT_STRIDE * 2 + c * 64);
            const u32x2 hi = *(const LAS u32x2*)(vbase + dt * 16 * VT_STRIDE * 2 + c * 64 + 32);
            const u32x4 av = {lo.x, lo.y, hi.x, hi.y};
            o[dt] = __builtin_amdgcn_mfma_f32_16x16x32_bf16(__builtin_bit_cast(bf16x8, av), pf[c], o[dt], 0, 0, 0);
        }
#pragma unroll
    for (int dt = 0; dt < 4; ++dt) { u32x2 w; w.x = pk2(o[dt][0], o[dt][1]); w.y = pk2(o[dt][2], o[dt][3]);
        *(u32x2*)(AO + (size_t)qrow * ATT + head * 64 + dt * 16 + 4 * g) = w; }
}

__device__ __forceinline__ void lds_put_kv(LAS unsigned char* lds, int key, int ch, u32x4 kv, u32x4 vv) {
    *(LAS u32x4*)(lds + key * (KS_STRIDE * 2) + ch * 16) = kv;
    LAS unsigned short* vt = (LAS unsigned short*)(lds + VT_OFF) + (ch * 8) * VT_STRIDE + key;
    vt[0 * VT_STRIDE] = (unsigned short)(vv.x & 0xffffu); vt[1 * VT_STRIDE] = (unsigned short)(vv.x >> 16);
    vt[2 * VT_STRIDE] = (unsigned short)(vv.y & 0xffffu); vt[3 * VT_STRIDE] = (unsigned short)(vv.y >> 16);
    vt[4 * VT_STRIDE] = (unsigned short)(vv.z & 0xffffu); vt[5 * VT_STRIDE] = (unsigned short)(vv.z >> 16);
    vt[6 * VT_STRIDE] = (unsigned short)(vv.w & 0xffffu); vt[7 * VT_STRIDE] = (unsigned short)(vv.w >> 16);
}
__device__ __forceinline__ void store8f(float* dst, const u32x4 v) { float f[8]; unpack8(v, f); *(f32x4*)dst = (f32x4){f[0], f[1], f[2], f[3]}; *(f32x4*)(dst + 4) = (f32x4){f[4], f[5], f[6], f[7]}; }

__device__ __forceinline__ void attn_prompt_unit(const Args& a, int l, int unit, const bf16_t* Z, bf16_t* AO, LAS unsigned char* lds, int tid, int wave, int lane) {
    const int b = unit >> 5, qb = (unit >> 1) & 15, kvh = unit & 1;
    const int rowbase = b * SEQ + qb * 128;
    const bool has_prev = qb > 0;
#pragma unroll
    for (int i = 0; i < 4; ++i) {
        const int item = tid + NTHREADS * i, key = item >> 3, ch = item & 7;
        u32x4 kv = {0u, 0u, 0u, 0u}, vv = {0u, 0u, 0u, 0u};
        if (has_prev || key >= 128) {
            const bf16_t* zr = Z + (size_t)(rowbase - 128 + key) * ZP + kvh * 64 + ch * 8;
            kv = *(const u32x4*)(zr + ZK); vv = *(const u32x4*)(zr + ZV);
            if (qb == 15 && key >= 128) {
                const size_t o = (((size_t)(l * NBATCH + b) * 128 + (key - 128)) * 2 + kvh) * 64 + ch * 8;
                store8f(a.out + O_KP + o, kv); store8f(a.out + O_VP + o, vv);
            }
        }
        lds_put_kv(lds, key, ch, kv, vv);
    }
    __syncthreads();
    const int hh = wave >> 1, half = wave & 1, head = kvh * 4 + hh;
    const float sink_l2 = a.in[10][l * 8 + head] * LOG2E;
#pragma unroll 1
    for (int qt = 0; qt < 4; ++qt) {
        const int iq0 = half * 64 + qt * 16, iq = iq0 + (lane & 15);
        attn_qtile<false>(lds, Z, AO, rowbase + iq, head, iq, (iq0 >> 4) & ~1, has_prev, sink_l2, lane);
    }
    __syncthreads();
}
__device__ __forceinline__ void attn_sample_unit(const Args& a, int l, int unit, const bf16_t* Z, bf16_t* AO, LAS unsigned char* lds, int tid, int wave, int lane) {
    const int n = unit >> 1, kvh = unit & 1;
    const float* ck = a.in[2] + ((size_t)(l * DBATCH + n) * 128) * 128 + kvh * 64;
    const float* cv = a.in[3] + ((size_t)(l * DBATCH + n) * 128) * 128 + kvh * 64;
#pragma unroll
    for (int i = 0; i < 3; ++i) {
        const int item = tid + NTHREADS * i, key = item >> 3, ch = item & 7;
        if (item < 160 * 8) {
            u32x4 kv = {0u, 0u, 0u, 0u}, vv = {0u, 0u, 0u, 0u};
            const size_t o = (((size_t)(l * DBATCH + n) * 128 + (key - 8)) * 2 + kvh) * 64 + ch * 8;
            if (key < 128) {
                const f32x4 k0 = *(const f32x4*)(ck + (size_t)key * 128 + ch * 8), k1 = *(const f32x4*)(ck + (size_t)key * 128 + ch * 8 + 4);
                const f32x4 v0 = *(const f32x4*)(cv + (size_t)key * 128 + ch * 8), v1 = *(const f32x4*)(cv + (size_t)key * 128 + ch * 8 + 4);
                kv = (u32x4){pk2(k0[0], k0[1]), pk2(k0[2], k0[3]), pk2(k1[0], k1[1]), pk2(k1[2], k1[3])};
                vv = (u32x4){pk2(v0[0], v0[1]), pk2(v0[2], v0[3]), pk2(v1[0], v1[1]), pk2(v1[2], v1[3])};
                if (key >= 8) { *(f32x4*)(a.out + O_KS + o) = k0; *(f32x4*)(a.out + O_KS + o + 4) = k1; *(f32x4*)(a.out + O_VS + o) = v0; *(f32x4*)(a.out + O_VS + o + 4) = v1; }
            } else if (key < 136) {
                const bf16_t* zr = Z + (size_t)(MP + n * DSEQ + (key - 128)) * ZP + kvh * 64 + ch * 8;
                kv = *(const u32x4*)(zr + ZK); vv = *(const u32x4*)(zr + ZV);
                store8f(a.out + O_KS + o, kv); store8f(a.out + O_VS + o, vv);
            }
            lds_put_kv(lds, key, ch, kv, vv);
        }
    }
    __syncthreads();
    if (wave < 2) {
        const int q = lane & 15, head = kvh * 4 + wave * 2 + (q >> 3), t = q & 7;
        const float sink_l2 = a.in[10][l * 8 + head] * LOG2E;
        attn_qtile<true>(lds, Z, AO, MP + n * DSEQ + t, head, t, 0, true, sink_l2, lane);
    }
    __syncthreads();
}

__device__ __forceinline__ void conv_phase(const Args& a, int l, const bf16_t* Z, bf16_t* BZ, int gtid, int nth) {
    const float* cw = a.in[11] + (size_t)l * 3 * CD;
    for (int item = gtid; item < M * 64; item += nth) {
        const int row = item >> 6, c0 = (item & 63) * 8;
        const bool smp = row >= MP;
        const int t = smp ? ((row - MP) & 7) : (row & (SEQ - 1));
        const int n = smp ? ((row - MP) >> 3) : (row >> 11);
        const bf16_t* zr = Z + (size_t)row * ZP + c0;
        float Bv[8], Cv[8], Uv[8], u2[8], u1[8], u0[8];
        unpack8(*(const u32x4*)(zr + ZB), Bv); unpack8(*(const u32x4*)(zr + ZC), Cv); unpack8(*(const u32x4*)(zr + ZU), Uv);
#pragma unroll
        for (int e = 0; e < 8; ++e) u2[e] = Cv[e] * Uv[e];
        if (t >= 1) { unpack8(*(const u32x4*)(zr - ZP + ZC), Cv); unpack8(*(const u32x4*)(zr - ZP + ZU), Uv);
#pragma unroll
            for (int e = 0; e < 8; ++e) u1[e] = Cv[e] * Uv[e];
        } else if (smp) { const float* sp = a.in[4] + ((size_t)(l * DBATCH + n) * 2 + 1) * CD + c0;
#pragma unroll
            for (int e = 0; e < 8; ++e) u1[e] = sp[e];
        } else {
#pragma unroll
            for (int e = 0; e < 8; ++e) u1[e] = 0.f;
        }
        if (t >= 2) { unpack8(*(const u32x4*)(zr - 2 * ZP + ZC), Cv); unpack8(*(const u32x4*)(zr - 2 * ZP + ZU), Uv);
#pragma unroll
            for (int e = 0; e < 8; ++e) u0[e] = Cv[e] * Uv[e];
        } else if (smp) { const float* sp = a.in[4] + ((size_t)(l * DBATCH + n) * 2 + t) * CD + c0;
#pragma unroll
            for (int e = 0; e < 8; ++e) u0[e] = sp[e];
        } else {
#pragma unroll
            for (int e = 0; e < 8; ++e) u0[e] = 0.f;
        }
        float o[8];
#pragma unroll
        for (int e = 0; e < 8; ++e) o[e] = Bv[e] * (cw[c0 + e] * u0[e] + cw[CD + c0 + e] * u1[e] + cw[2 * CD + c0 + e] * u2[e]);
        *(u32x4*)(BZ + (size_t)row * CD + c0) = pack8(o);
        const int tl = smp ? DSEQ : SEQ;
        if (t >= tl - 2) {
            float* dst = smp ? a.out + O_CS + ((size_t)(l * DBATCH + n) * 2 + (t - (tl - 2))) * CD + c0 : a.out + O_CP + ((size_t)(l * NBATCH + n) * 2 + (t - (tl - 2))) * CD + c0;
            *(f32x4*)dst = (f32x4){u2[0], u2[1], u2[2], u2[3]}; *(f32x4*)(dst + 4) = (f32x4){u2[4], u2[5], u2[6], u2[7]};
        }
    }
}


#define RLX_AGENT __ATOMIC_RELAXED, __HIP_MEMORY_SCOPE_AGENT
#define XB_TMO      128
#define XB_XCNT(j)  (256  + 64 * (j))
#define XB_XSUB(j)  (1280 + 64 * (j))
#define XB_XGEN(j)  (2304 + 64 * (j))
#define XB_TOP      3328
#define XB_TOPGEN   3392
#define XCD_BAR_WORDS 3456
#define XB_SPIN_CAP (1u << 18)

__device__ __forceinline__ unsigned xb_ld(unsigned* p)              { return __hip_atomic_load(p, __ATOMIC_RELAXED, __HIP_MEMORY_SCOPE_AGENT); }
__device__ __forceinline__ unsigned xb_add(unsigned* p, unsigned v) { return __hip_atomic_fetch_add(p, v, __ATOMIC_RELAXED, __HIP_MEMORY_SCOPE_AGENT); }
__device__ __forceinline__ unsigned xb_xcc_id() { return (unsigned)__builtin_amdgcn_s_getreg((3 << 11) | 20) & 0xFu; }
#define XB_SPIN(cond, bar) do { unsigned _sp = 0; while (cond) { __builtin_amdgcn_s_sleep(1); \
    if ((++_sp & 255u) == 0u) { if (xb_ld(&(bar)[XB_TMO])) break; if (_sp > XB_SPIN_CAP) { atomicAdd(&(bar)[XB_TMO], 1u); break; } } } } while (0)

struct XcdBarrier {
    unsigned* bar; unsigned x;
    volatile LAS unsigned* st;
};

__device__ __forceinline__ XcdBarrier xcd_barrier_post(unsigned* bar, volatile LAS unsigned* st) {
    XcdBarrier b; b.bar = bar; b.x = xb_xcc_id(); b.st = st;
    if (threadIdx.x == 0) (void)xb_add(&bar[XB_XCNT(b.x)], 1u);
    return b;
}
__device__ __forceinline__ void xcd_barrier_complete(unsigned* bar, unsigned x, unsigned& nloc, unsigned& nx) {
    const unsigned G = gridDim.x * gridDim.y * gridDim.z;
    unsigned sum, cnt, mine, sp = 0u;
    for (;;) {
        sum = 0u; cnt = 0u; mine = 0u;
#pragma unroll
        for (unsigned j = 0; j < 16; ++j) { const unsigned c = xb_ld(&bar[XB_XCNT(j)]); sum += c; cnt += (c > 0u) ? 1u : 0u; mine = (j == x) ? c : mine; }
        if (sum == G) break;
        __builtin_amdgcn_s_sleep(1);
        if ((++sp & 255u) == 0u) { if (xb_ld(&bar[XB_TMO])) break; if (sp > XB_SPIN_CAP) { atomicAdd(&bar[XB_TMO], 1u); break; } }
    }
    nloc = mine > 0u ? mine : 1u; nx = cnt > 0u ? cnt : 1u;
}

__device__ __forceinline__ void xcd_barrier(const XcdBarrier& b) {
    asm volatile("s_waitcnt vmcnt(0)" ::: "memory");
    __syncthreads();
    if (threadIdx.x == 0) {
        unsigned* bar = b.bar;
        __builtin_amdgcn_s_waitcnt(0);
        unsigned nloc = b.st[0], nx = b.st[1];
        if (nloc == 0u) { xcd_barrier_complete(bar, b.x, nloc, nx); b.st[0] = nloc; b.st[1] = nx; }
        const unsigned old = xb_add(&bar[XB_XSUB(b.x)], 1u);
        const unsigned gen = old / nloc;
        if (old + 1u == (gen + 1u) * nloc) {
            __builtin_amdgcn_fence(__ATOMIC_RELEASE, "agent");
            asm volatile("s_waitcnt vmcnt(0)" ::: "memory");
            const unsigned og = xb_add(&bar[XB_TOP], 1u);
            const unsigned tg = og / nx;
            if (og + 1u == (tg + 1u) * nx) xb_add(&bar[XB_TOPGEN], 1u);
            else XB_SPIN(xb_ld(&bar[XB_TOPGEN]) == tg, bar);
            __builtin_amdgcn_fence(__ATOMIC_ACQUIRE, "agent");
            xb_add(&bar[XB_XGEN(b.x)], 1u);
            asm volatile("s_waitcnt vmcnt(0)" ::: "memory");
        } else {
            XB_SPIN(xb_ld(&bar[XB_XGEN(b.x)]) == gen, bar);
            __builtin_amdgcn_fence(__ATOMIC_ACQUIRE, "agent");
            asm volatile("s_waitcnt vmcnt(0)" ::: "memory");
        }
    }
    __syncthreads();
}
__global__ void __launch_bounds__(NTHREADS, 2) fwd_megakernel(Args a) {
    extern __shared__ __attribute__((aligned(16))) unsigned char lds_raw[];
    LAS unsigned char* lds = (LAS unsigned char*)lds_raw;
    cg::grid_group grid = cg::this_grid();
    const int G = gridDim.x, bx = blockIdx.x, NGW = G * NWAVES;
#define FRESH() int tid = threadIdx.x; asm volatile("" : "+v"(tid)); const int lane = tid & 63, wave = __builtin_amdgcn_readfirstlane(tid >> 6), gw = bx * NWAVES + wave; (void)lane; (void)gw
    unsigned char* ws = a.ws;
    float* R = (float*)(ws + WS_R);
    bf16_t* Wb = (bf16_t*)(ws + WS_W);
    bf16_t* Z = (bf16_t*)(ws + WS_Z);
    bf16_t* S1 = (bf16_t*)(ws + WS_S1);
    bf16_t* S2 = (bf16_t*)(ws + WS_S2);
    float* Y = a.out + O_Y;

    unsigned* barw = (unsigned*)(ws + WS_BAR);
    volatile LAS unsigned* bst = (volatile LAS unsigned*)(lds + 131072 + 64);
    { FRESH(); if (tid < 2) bst[tid] = 0u;
      if (bx == 0) for (int i = tid; i < XCD_BAR_WORDS; i += NTHREADS) __hip_atomic_store(barw + i, 0u, RLX_AGENT);
      convert_weights(a, 0, Wb, lds, gw, NGW, wave, lane);
      rows_prologue(a.in[0], a.in[1], S2, R, gw, NGW, lane); }
    grid.sync();
    const XcdBarrier xbar = xcd_barrier_post(barw, bst);
#define GSYNC() xcd_barrier(xbar)

#pragma unroll 1
    for (int l = 0; l < DEPTH; ++l) {
#ifndef PHM
#define PHM 0xff
#endif
        if (PHM & 1) {
            pg8::Gemm g{S2, Wb + W_IN, M, IN_DIM, DM}; pg8::StaticOrder S; S.init(M, IN_DIM, G, bx);
            Epi<1> E{Z, ZP, R, Z};
            pg8::gemm_phase<Epi<1>, pg8::StaticOrder, true, true>(lds, g, S, E);
        }
        GSYNC();
        if (PHM & 2) {
            FRESH();
            for (int u = bx; u < NBATCH * 16 * 2; u += G) attn_prompt_unit(a, l, u, Z, S1, lds, tid, wave, lane);
            for (int u = bx; u < DBATCH * 2; u += G) attn_sample_unit(a, l, u, Z, S1, lds, tid, wave, lane);
            conv_phase(a, l, Z, S1 + (size_t)M * ATT, bx * NTHREADS + tid, G * NTHREADS);
        }
        GSYNC();
        if (PHM & 4) {
            pg8::Gemm g{S1, Wb + W_BR, 2 * M, 2048, 512}; PairOrder S; S.init(M, DM, G, bx);
            Epi<3> E{S2, DM, R, Z};
            pg8::gemm_phase<Epi<3>, PairOrder, true, true>(lds, g, S, E);
        }
        GSYNC();
        if (PHM & 8) {
            pg8::Gemm g{S2, Wb + W_OUT, M, DM, DM}; pg8::StaticOrder S; S.init(M, DM, G, bx);
            Epi<4> E{S1, DM, R, Z};
            pg8::gemm_phase<Epi<4>, pg8::StaticOrder, true, true>(lds, g, S, E);
        }
        GSYNC();
        { FRESH(); rows_residual(S1, l == 0 ? a.in[0] : Y, l == 0 ? a.in[1] : Y + (size_t)MP * DM, a.in[6] + l * DM, Y, S2, R, gw, NGW, lane); }
        GSYNC();
        if (PHM & 16) {
            pg8::Gemm g{S2, Wb + W_UP, M, FF, DM}; pg8::StaticOrder S; S.init(M, FF, G, bx);
            Epi<6> E{Z, FF, R, Z};
            pg8::gemm_phase<Epi<6>, pg8::StaticOrder, true, true>(lds, g, S, E);
        }
        GSYNC();
        if (PHM & 32) {
            pg8::Gemm g{Z, Wb + W_DN, M, DM, FF}; pg8::StaticOrder S; S.init(M, DM, G, bx);
            Epi<4> E{S1, DM, R, Z};
            pg8::gemm_phase<Epi<4>, pg8::StaticOrder, true, true>(lds, g, S, E);
        }
        GSYNC();
        { FRESH(); rows_residual(S1, Y, Y + (size_t)MP * DM, a.in[8] + l * DM, Y, S2, R, gw, NGW, lane);
          if (l + 1 < DEPTH) convert_weights(a, l + 1, Wb, lds, gw, NGW, wave, lane); }
        if (l + 1 < DEPTH) GSYNC();
    }
}

extern "C" void kernel_launch(void* const* d_in, const int* in_sizes, int n_in, void* d_out, int out_size, void* d_ws, size_t ws_size, hipStream_t stream) {
    static int grid = 0;
    if (grid == 0) {
        if (n_in != 17 || ws_size < WS_END) { fprintf(stderr, "kernel_launch: unexpected n_in %d / ws_size %zu (need %zu)\n", n_in, ws_size, (size_t)WS_END); grid = -1; return; }
        int dev = 0, cus = 0, per_cu = 0;
        hipGetDevice(&dev);
        hipDeviceGetAttribute(&cus, hipDeviceAttributeMultiprocessorCount, dev);
        if (hipFuncSetAttribute((const void*)fwd_megakernel, hipFuncAttributeMaxDynamicSharedMemorySize, LDS_BYTES) != hipSuccess) fprintf(stderr, "kernel_launch: hipFuncSetAttribute failed\n");
        if (hipOccupancyMaxActiveBlocksPerMultiprocessor(&per_cu, (const void*)fwd_megakernel, NTHREADS, LDS_BYTES) != hipSuccess || per_cu < 1) { fprintf(stderr, "kernel_launch: occupancy query gave %d\n", per_cu); per_cu = 1; }
        (void)hipGetLastError();
        grid = cus * per_cu;
    }
    if (grid < 0) return;
    Args a{};
    for (int i = 0; i < 17; ++i) a.in[i] = (const float*)d_in[i];
    a.out = (float*)d_out; a.ws = (unsigned char*)d_ws;
    void* args[] = {&a};
    hipError_t e = hipLaunchCooperativeKernel((const void*)fwd_megakernel, dim3(grid), dim3(NTHREADS), args, LDS_BYTES, stream);
    if (e != hipSuccess) fprintf(stderr, "cooperative launch failed: %s (grid %d)\n", hipGetErrorString(e), grid);
}
```

```cpp
#include <hip/hip_runtime.h>
#include <hip/hip_cooperative_groups.h>
#include <cstdio>
#include <cstdint>
namespace cg = cooperative_groups;
namespace pg8 {
#define PG8_LAS __attribute__((address_space(3)))
typedef unsigned short bf16_t;
typedef short bf16x8 __attribute__((ext_vector_type(8)));
typedef float f32x4 __attribute__((ext_vector_type(4)));
typedef unsigned u32x4 __attribute__((ext_vector_type(4)));
constexpr int BM = 256, BK = 64, HALF = 128, HTB = HALF * BK * 2  , STAGE_BYTES = 8 * HTB, NXCD = 8, WGM = 8;

__host__ __device__ __forceinline__ int lds_byte(int r, int c) { const int st = (r >> 4) * 2 + (c >> 5), rr = r & 15, cc = c & 31, ob = rr * 64 + cc * 2; return st * 1024 + (ob ^ (((ob >> 9) & 1) << 5)); }
__host__ __device__ __forceinline__ void stage_rc(int b, int& R, int& C) { const int st = b / 1024, sb = b % 1024, swz = sb ^ (((sb >> 9) & 1) << 5); R = (st >> 1) * 16 + swz / 64; C = (st & 1) * 32 + (swz % 64) / 2; }
__host__ __device__ __forceinline__ int perm32(int rho) { const int n = rho >> 4, i = rho & 15; return 8 * (i >> 2) + 4 * n + (i & 3); }

struct Unit { int pm, pn, pa, pb, w, koff, nt; };
struct Gemm { const bf16_t* A; const bf16_t* Bt; int M, N, K; };

struct StaticOrder {
    int nM, nN, nwg, G, c;
    __host__ __device__ __forceinline__ void init(int M, int N, int G_, int c_) { nM = M / BM; nN = N / BM; nwg = nM * nN; G = G_; c = c_; }
    __host__ __device__ __forceinline__ bool next(int i, Unit& u) const {
        const long L = (long)i * G + c; if (L >= nwg) return false;
        int wgid = (int)L; { const int q = nwg / NXCD, r = nwg % NXCD, xcd = wgid % NXCD, off = wgid / NXCD; wgid = (xcd < r ? xcd * (q + 1) : r * (q + 1) + (xcd - r) * q) + off; }
        const int nig = WGM * nN, gid = wgid / nig, fm = gid * WGM, gsz = (nM - fm) < WGM ? (nM - fm) : WGM;
        u.pm = fm + ((wgid % nig) % gsz); u.pn = (wgid % nig) / gsz; u.pa = u.pm; u.pb = u.pn; u.w = 0; u.koff = 0; u.nt = 0; return true;
    }
    __device__ __forceinline__ void a_ready(const Unit&) const {}
    __device__ __forceinline__ void done(const Unit&) const {}
};
__device__ __forceinline__ unsigned cvt_pk_bf16(float lo, float hi) { unsigned r; asm volatile("v_cvt_pk_bf16_f32 %0, %1, %2" : "=v"(r) : "v"(lo), "v"(hi)); return r; }
template <class Epi, class Sched, bool ALIGN_EPI = false, bool SP2 = false>
__device__ __forceinline__ void gemm_phase(PG8_LAS unsigned char* lds, const Gemm g, const Sched& S, const Epi& E) {
    int tid_ = threadIdx.x; asm volatile("" : "+v"(tid_));
    const int tid = tid_, wid = __builtin_amdgcn_readfirstlane(tid >> 6), lane = tid & 63, wr = wid >> 2, wc = wid & 3, fr = lane & 15, fq = lane >> 4;
    const int K = g.K, nt = K / BK;
    unsigned voffA[2], voffB[2];
#pragma unroll
    for (int i = 0; i < 2; ++i) { int R, C; stage_rc(tid * 16 + i * 8192, R, C); const int Rb = Epi::PERM ? ((R & ~31) + perm32(R & 31)) : R;
        voffA[i] = (unsigned)(R * K + C) * 2u; voffB[i] = (unsigned)(Rb * K + C) * 2u; }
    const size_t kstep = (size_t)(BK * 2);
    const size_t hstep = (size_t)HALF * K * 2;
    const size_t tstep = 2 * hstep;
    const unsigned ldsw = (unsigned)wid * 1024u;
    const int aoff = lds_byte(wr * 64 + fr, fq * 8), boff = lds_byte(wc * 32 + fr, fq * 8);
#define PG8_SA(b, h) (((b) * 2 + (h)) * HTB)
#define PG8_SB(b, h) ((4 + (b) * 2 + (h)) * HTB)
#define PG8_STAGE(bufoff, gbase, voff) do { _Pragma("unroll") for (int _i = 0; _i < 2; ++_i) \
        __builtin_amdgcn_global_load_lds((const unsigned*)((const char*)(gbase) + (voff)[_i]), (PG8_LAS unsigned*)(lds + (bufoff) + ldsw + _i * 8192), 16, 0, 0); } while (0)
#define PG8_LDA(dst, b, h) do { _Pragma("unroll") for (int m = 0; m < 4; ++m) _Pragma("unroll") for (int k = 0; k < 2; ++k) dst[m][k] = *(const PG8_LAS bf16x8*)(lds + PG8_SA(b, h) + aoff + m * 2048 + k * 1024); } while (0)
#define PG8_LDB(dst, b, h) do { _Pragma("unroll") for (int n = 0; n < 2; ++n) _Pragma("unroll") for (int k = 0; k < 2; ++k) dst[n][k] = *(const PG8_LAS bf16x8*)(lds + PG8_SB(b, h) + boff + n * 2048 + k * 1024); } while (0)
#define PG8_MMA(ai, bj, At, Bt) do { __builtin_amdgcn_s_setprio(1); _Pragma("unroll") for (int m = 0; m < 4; ++m) _Pragma("unroll") for (int n = 0; n < 2; ++n) _Pragma("unroll") for (int k = 0; k < 2; ++k) \
        acc[ai][bj][m][n] = __builtin_amdgcn_mfma_f32_16x16x32_bf16(Bt[n][k], At[m][k], acc[ai][bj][m][n], 0, 0, 0); __builtin_amdgcn_s_setprio(0); } while (0)
#define PG8_WAIT_V(n) asm volatile("s_waitcnt vmcnt(" #n ")" ::: "memory")
#define PG8_WAIT_L(n) asm volatile("s_waitcnt lgkmcnt(" #n ")" ::: "memory")
#define PG8_BAR __builtin_amdgcn_s_barrier()
#define PG8_SCHED __builtin_amdgcn_sched_barrier(0)
    Unit cur, nxt; int ui = 0;
    if (!S.next(0, cur)) return;
    f32x4 acc[2][2][4][2];
#pragma unroll
    for (int a = 0; a < 2; ++a)
#pragma unroll
        for (int b = 0; b < 2; ++b)
#pragma unroll
            for (int m = 0; m < 4; ++m)
#pragma unroll
                for (int n = 0; n < 2; ++n) acc[a][b][m][n] = (f32x4){0.f, 0.f, 0.f, 0.f};
    bf16x8 At[4][2], B0[2][2], B1[2][2];
    const char* cA = (const char*)g.A + (size_t)cur.pa * tstep + cur.koff; const char* cB = (const char*)g.Bt + (size_t)cur.pb * tstep + cur.koff;
    S.a_ready(cur);
    if constexpr (SP2) {
        PG8_STAGE(PG8_SB(0, 0), cB, voffB); PG8_STAGE(PG8_SB(0, 1), cB + hstep, voffB); PG8_STAGE(PG8_SA(0, 0), cA, voffA); PG8_STAGE(PG8_SA(0, 1), cA + hstep, voffA);
        if (wr == 1) PG8_BAR;
        PG8_WAIT_V(2); PG8_BAR;
        PG8_STAGE(PG8_SB(1, 0), cB + kstep, voffB); PG8_STAGE(PG8_SA(1, 0), cA + kstep, voffA); PG8_STAGE(PG8_SB(1, 1), cB + hstep + kstep, voffB);
        PG8_WAIT_V(6); PG8_BAR;
    } else {
        PG8_STAGE(PG8_SB(0, 0), cB, voffB); PG8_STAGE(PG8_SA(0, 0), cA, voffA); PG8_STAGE(PG8_SB(0, 1), cB + hstep, voffB); PG8_STAGE(PG8_SA(0, 1), cA + hstep, voffA);
        if (wr == 1) PG8_BAR;
        PG8_WAIT_V(4); PG8_BAR;
        PG8_STAGE(PG8_SB(1, 0), cB + kstep, voffB); PG8_STAGE(PG8_SA(1, 0), cA + kstep, voffA); PG8_STAGE(PG8_SB(1, 1), cB + hstep + kstep, voffB);
        PG8_WAIT_V(6); PG8_BAR;
    }
    for (;;) {
        const bool has_next = S.next(ui + 1, nxt);
        const char* nA = has_next ? (const char*)g.A + (size_t)nxt.pa * tstep + nxt.koff : cA; const char* nB = has_next ? (const char*)g.Bt + (size_t)nxt.pb * tstep + nxt.koff : cB;
        const int unt = cur.nt ? cur.nt : nt;
        for (int t = 0; t < unt; t += 2) {
            const bool last = (t == unt - 2);
            const char* a1 = cA + (size_t)(t + 1) * kstep;
            const char* a2 = last ? nA : cA + (size_t)(t + 2) * kstep; const char* b2 = last ? nB : cB + (size_t)(t + 2) * kstep;
            const char* a3 = a2 + kstep; const char* b3 = b2 + kstep;
            if (last && has_next) S.a_ready(nxt);
            if constexpr (SP2) {
            PG8_LDB(B0, 0, 0); PG8_LDB(B1, 0, 1); PG8_SCHED; PG8_LDA(At, 0, 0); PG8_STAGE(PG8_SA(1, 1), a1 + hstep, voffA);
            PG8_WAIT_V(8); PG8_WAIT_L(0); PG8_BAR; PG8_MMA(0, 0, At, B0); PG8_MMA(0, 1, At, B1); PG8_BAR; PG8_SCHED;
            PG8_LDA(At, 0, 1); PG8_STAGE(PG8_SB(0, 0), b2, voffB); PG8_STAGE(PG8_SB(0, 1), b2 + hstep, voffB); PG8_STAGE(PG8_SA(0, 0), a2, voffA);
            PG8_WAIT_V(8); PG8_WAIT_L(0); PG8_BAR; PG8_MMA(1, 0, At, B0); PG8_MMA(1, 1, At, B1); PG8_BAR; PG8_SCHED;
            PG8_LDB(B0, 1, 0); PG8_LDB(B1, 1, 1); PG8_SCHED; PG8_LDA(At, 1, 0); PG8_STAGE(PG8_SA(0, 1), a2 + hstep, voffA);
            PG8_WAIT_V(8); PG8_WAIT_L(0); PG8_BAR; PG8_MMA(0, 0, At, B0); PG8_MMA(0, 1, At, B1); PG8_BAR; PG8_SCHED;
            PG8_LDA(At, 1, 1); PG8_STAGE(PG8_SB(1, 0), b3, voffB); PG8_STAGE(PG8_SB(1, 1), b3 + hstep, voffB); PG8_STAGE(PG8_SA(1, 0), a3, voffA);
            PG8_WAIT_V(8); PG8_WAIT_L(0); PG8_BAR; PG8_MMA(1, 0, At, B0); PG8_MMA(1, 1, At, B1); PG8_BAR; PG8_SCHED;
            } else {
            PG8_LDB(B0, 0, 0); PG8_SCHED; PG8_LDA(At, 0, 0); PG8_STAGE(PG8_SA(1, 1), a1 + hstep, voffA);
            PG8_WAIT_L(8); PG8_BAR; PG8_WAIT_L(0); PG8_MMA(0, 0, At, B0); PG8_BAR; PG8_SCHED;
            PG8_LDB(B1, 0, 1); PG8_STAGE(PG8_SB(0, 0), b2, voffB);
            PG8_BAR; PG8_WAIT_L(0); PG8_MMA(0, 1, At, B1); PG8_BAR;
            PG8_LDA(At, 0, 1); PG8_STAGE(PG8_SA(0, 0), a2, voffA);
            PG8_BAR; PG8_WAIT_L(0); PG8_MMA(1, 0, At, B0); PG8_BAR; PG8_SCHED;
            PG8_STAGE(PG8_SB(0, 1), b2 + hstep, voffB);
            PG8_WAIT_V(6); PG8_BAR; PG8_MMA(1, 1, At, B1); PG8_BAR;
            PG8_LDB(B0, 1, 0); PG8_SCHED; PG8_LDA(At, 1, 0); PG8_STAGE(PG8_SA(0, 1), a2 + hstep, voffA);
            PG8_WAIT_L(8); PG8_BAR; PG8_WAIT_L(0); PG8_MMA(0, 0, At, B0); PG8_BAR; PG8_SCHED;
            PG8_LDB(B1, 1, 1); PG8_STAGE(PG8_SB(1, 0), b3, voffB);
            PG8_BAR; PG8_WAIT_L(0); PG8_MMA(0, 1, At, B1); PG8_BAR;
            PG8_LDA(At, 1, 1); PG8_STAGE(PG8_SA(1, 0), a3, voffA);
            PG8_BAR; PG8_WAIT_L(0); PG8_MMA(1, 0, At, B0); PG8_BAR; PG8_SCHED;
            PG8_STAGE(PG8_SB(1, 1), b3 + hstep, voffB);
            PG8_WAIT_V(6); PG8_BAR; PG8_MMA(1, 1, At, B1); PG8_BAR;
            }
        }
        if constexpr (ALIGN_EPI) { if (wr == 0) PG8_BAR; }
        if constexpr (!Epi::AFTER_DRAIN) { E(acc, cur, wr, wc, fr, fq); S.done(cur); }
        if (!has_next) break;
#pragma unroll
        for (int a = 0; a < 2; ++a)
#pragma unroll
            for (int b = 0; b < 2; ++b)
#pragma unroll
                for (int m = 0; m < 4; ++m)
#pragma unroll
                    for (int n = 0; n < 2; ++n) acc[a][b][m][n] = (f32x4){0.f, 0.f, 0.f, 0.f};
        cur = nxt; cA = nA; cB = nB; ++ui;
        if constexpr (ALIGN_EPI) { if (wr == 1) PG8_BAR; }
    }
    PG8_WAIT_V(0);
    if constexpr (!ALIGN_EPI) { if (wr == 0) PG8_BAR; }
    PG8_BAR;
    if constexpr (Epi::AFTER_DRAIN) { E.fused(acc, cur, wr, wc, fr, fq, lds, wid, lane); S.done(cur); }
#undef PG8_SA
#undef PG8_SB
#undef PG8_STAGE
#undef PG8_LDA
#undef PG8_LDB
#undef PG8_MMA
#undef PG8_WAIT_V
#undef PG8_WAIT_L
#undef PG8_BAR
#undef PG8_SCHED
}
}
#define LAS __attribute__((address_space(3)))
#define CAS __attribute__((address_space(4)))
typedef unsigned short bf16_t;
typedef short bf16x8 __attribute__((ext_vector_type(8)));
typedef float f32x4 __attribute__((ext_vector_type(4)));
typedef unsigned u32x4 __attribute__((ext_vector_type(4)));
typedef unsigned u32x2 __attribute__((ext_vector_type(2)));

constexpr int DM = 1024, NBATCH = 8, SEQ = 2048, DEPTH = 2, DBATCH = 128, DSEQ = 8;
constexpr int MP = NBATCH * SEQ, MS = DBATCH * DSEQ, M = MP + MS;
constexpr int IN_DIM = 4352, ATT = 512, CD = 512, FF = 4096;
constexpr int ZP = IN_DIM;
constexpr int ZQ = 0, ZK = 512, ZV = 640, ZB = 768, ZC = 1280, ZU = 1792, ZGA = 2304;
constexpr float EPS = 1e-6f;
constexpr float LOG2E = 1.4426950408889634f;

constexpr size_t O_Y = 0;
constexpr size_t O_KP = (size_t)M * DM;
constexpr size_t O_VP = O_KP + 2 * 8 * 128 * 128;
constexpr size_t O_CP = O_VP + 2 * 8 * 128 * 128;
constexpr size_t O_KS = O_CP + 2 * 8 * 2 * 512;
constexpr size_t O_VS = O_KS + (size_t)2 * 128 * 128 * 128;
constexpr size_t O_CS = O_VS + (size_t)2 * 128 * 128 * 128;

constexpr size_t MiB = 1u << 20;
constexpr size_t WS_R = 0;
constexpr size_t WS_BAR = 512 * 1024;
constexpr size_t WS_W = 3 * MiB;
constexpr size_t W_IN = 0, W_BR = W_IN + (size_t)IN_DIM * DM, W_OUT = W_BR + (size_t)2048 * 512, W_UP = W_OUT + (size_t)DM * DM, W_DN = W_UP + (size_t)FF * DM, W_END = W_DN + (size_t)DM * FF;
constexpr size_t WS_Z = 32 * MiB;
constexpr size_t WS_S1 = 177 * MiB;
constexpr size_t WS_S2 = 211 * MiB;
constexpr size_t WS_END = 247 * MiB;
constexpr int NSL = 8;
static_assert(WS_W + W_END * 2 <= WS_Z && WS_Z + (size_t)M * ZP * 2 <= WS_S1 && WS_S1 + (size_t)M * DM * 2 <= WS_S2 && WS_S2 + (size_t)(M + 1024) * DM * 2 <= WS_END, "ws map");

constexpr int LDS_BYTES = 147456;
constexpr int NTHREADS = 512, NWAVES = 8;

__device__ __forceinline__ float bf2f(unsigned b) { return __uint_as_float(b << 16); }
typedef float f32x2_t __attribute__((ext_vector_type(2))); typedef __bf16 bf16x2_t __attribute__((ext_vector_type(2)));
__device__ __forceinline__ unsigned pk2(float lo, float hi) { const f32x2_t v = {lo, hi}; const bf16x2_t b = __builtin_convertvector(v, bf16x2_t); return __builtin_bit_cast(unsigned, b); }
__device__ __forceinline__ float wave_sum(float v) {
#pragma unroll
    for (int o = 1; o < 64; o <<= 1) v += __shfl_xor(v, o);
    return v;
}
__device__ __forceinline__ void unpack8(const u32x4 v, float (&f)[8]) {
    f[0] = bf2f(v.x & 0xffffu); f[1] = __uint_as_float(v.x & 0xffff0000u); f[2] = bf2f(v.y & 0xffffu); f[3] = __uint_as_float(v.y & 0xffff0000u);
    f[4] = bf2f(v.z & 0xffffu); f[5] = __uint_as_float(v.z & 0xffff0000u); f[6] = bf2f(v.w & 0xffffu); f[7] = __uint_as_float(v.w & 0xffff0000u);
}
__device__ __forceinline__ u32x4 pack8(const float (&f)[8]) { u32x4 w; w.x = pk2(f[0], f[1]); w.y = pk2(f[2], f[3]); w.z = pk2(f[4], f[5]); w.w = pk2(f[6], f[7]); return w; }
__device__ __forceinline__ float sigmoidf_fast(float x) { return __builtin_amdgcn_rcpf(1.0f + __builtin_amdgcn_exp2f(-x * LOG2E)); }

template <int MODE> struct Epi {
    static constexpr bool PERM = true, AFTER_DRAIN = false;
    bf16_t* O; int ldc; const float* r; const bf16_t* Z; float* part;
    __device__ __forceinline__ void operator()(const f32x4 (&acc)[2][2][4][2], const pg8::Unit& u, int wr, int wc, int fr, int fq) const {
        const int row0 = u.pm * 256 + wr * 64 + fr, col0 = u.pn * 256 + wc * 32 + 8 * fq;
#pragma unroll
        for (int ai = 0; ai < 2; ++ai)
#pragma unroll
            for (int m = 0; m < 4; ++m) {
                const int row = row0 + ai * 128 + m * 16;
                float rs = 1.f;
                if (MODE == 1 || MODE == 6) rs = r[row];
#pragma unroll
                for (int bj = 0; bj < 2; ++bj) {
                    const int col = col0 + bj * 128;
                    const f32x4 a0 = acc[ai][bj][m][0], a1 = acc[ai][bj][m][1];
                    float v[8] = {a0[0], a0[1], a0[2], a0[3], a1[0], a1[1], a1[2], a1[3]};
                    if (MODE == 4 && u.pm >= MP / 256) {
                        float* pd = part + ((size_t)u.w * MS + (row - MP)) * DM + col;
                        *(f32x4*)pd = a0; *(f32x4*)(pd + 4) = a1; continue; }
                    bf16_t* dst = O + (size_t)(row + ((MODE == 3 && u.pm >= MP / 256) ? u.w * MS : 0)) * ldc + col;
                    if (MODE == 1) {
#pragma unroll
                        for (int e = 0; e < 8; ++e) v[e] *= rs;
                        if (u.pn >= 9) {
#pragma unroll
                            for (int e = 0; e < 8; ++e) v[e] = sigmoidf_fast(v[e]);
                        }
                    } else if (MODE == 3) {
                        float gt[8]; unpack8(*(const u32x4*)(Z + (size_t)row * ZP + ZGA + u.w * 1024 + col), gt);
#pragma unroll
                        for (int e = 0; e < 8; ++e) v[e] *= gt[e];
                        if (u.w == 1 && u.pm < MP / 256) { float t[8]; unpack8(*(const u32x4*)dst, t);
#pragma unroll
                            for (int e = 0; e < 8; ++e) v[e] += t[e]; }
                    } else if (MODE == 6) {
#pragma unroll
                        for (int e = 0; e < 8; ++e) { const float q = fmaxf(v[e] * rs, 0.f); v[e] = q * q; }
                    }
                    *(u32x4*)dst = pack8(v);
                }
            }
    }
};

struct PairOrder {
    pg8::StaticOrder so; int c;
    __device__ __forceinline__ void init(int G_, int c_) { so.init(MP, DM, G_, c_); c = c_; }
    __device__ __forceinline__ bool next(int i, pg8::Unit& u) const {
        const int np = (so.nwg - c + so.G - 1) / so.G;
        pg8::Unit t; t.pm = 0; t.pn = 0; t.pa = 0; t.pb = 0; t.w = 0; t.koff = 0; t.nt = 0;
        bool ok;
        if (i < 2 * np) { ok = so.next(i >> 1, t); t.w = i & 1; }
        else { const int j = (i - 2 * np) * so.G + c; ok = j < 32; t.pm = MP / 256 + ((j >> 3) & 3); t.pn = (j >> 1) & 3; t.w = j & 1; }
        t.koff = 0; t.nt = 0; t.pa = t.w * (M / 256) + t.pm; t.pb = t.w * 4 + t.pn; u = t; return ok; }
    __device__ __forceinline__ void a_ready(const pg8::Unit&) const {}
    __device__ __forceinline__ void done(const pg8::Unit&) const {}
};
struct SliceOrder {
    pg8::StaticOrder so; int c, ntl, wrapk;
    __device__ __forceinline__ void init(int G_, int c_, int ntl_, int wrapk_) { so.init(MP, DM, G_, c_); c = c_; ntl = ntl_; wrapk = wrapk_; }
    __device__ __forceinline__ bool next(int i, pg8::Unit& u) const {
        const int nsl = (c < 16 * NSL) ? (16 * NSL - c + so.G - 1) / so.G : 0;
        pg8::Unit t; t.pm = 0; t.pn = 0; t.pa = 0; t.pb = 0; t.w = 0; t.koff = 0; t.nt = 0;
        bool ok;
        if (i < nsl) { const int j = i * so.G + c, tile = j / NSL, s = j % NSL, kt0 = s * ntl, src = kt0 / wrapk; ok = true;
            t.pm = MP / 256 + (tile >> 2); t.pn = tile & 3; t.w = s; t.pa = MP / 256 + src * 4 + (tile >> 2); t.pb = t.pn; t.koff = (kt0 % wrapk) * 128; t.nt = ntl; }
        else ok = so.next(i - nsl, t);
        u = t; return ok; }
    __device__ __forceinline__ void a_ready(const pg8::Unit&) const {}
    __device__ __forceinline__ void done(const pg8::Unit&) const {}
};

__device__ __forceinline__ void transpose_item(const float* W, const float* gk, int K, int N, bf16_t* WT, int row_off, LAS float* scr, int item, int lane) {
    const int nblk = N / 32, kb = item / nblk, nb = item % nblk, k0 = 64 * kb, n0 = 32 * nb;
#pragma unroll 8
    for (int i = 0; i < 32; ++i) { const int kk = 2 * i + (lane >> 5); float w = W[(size_t)(k0 + kk) * N + n0 + (lane & 31)]; if (gk) w *= gk[k0 + kk]; scr[kk * 33 + (lane & 31)] = w; }
    asm volatile("s_waitcnt lgkmcnt(0)" ::: "memory");
    const int c = lane & 7;
#pragma unroll
    for (int j = 0; j < 4; ++j) { const int n = (lane >> 3) + 8 * j; const LAS float* s = scr + (8 * c) * 33 + n;
        u32x4 o; o.x = pk2(s[0 * 33], s[1 * 33]); o.y = pk2(s[2 * 33], s[3 * 33]); o.z = pk2(s[4 * 33], s[5 * 33]); o.w = pk2(s[6 * 33], s[7 * 33]);
        *(u32x4*)(WT + (size_t)(row_off + n0 + n) * K + k0 + 8 * c) = o; }
    asm volatile("s_waitcnt lgkmcnt(0)" ::: "memory");
}
struct Args { const float* in[17]; float* out; unsigned char* ws; };

__device__ __forceinline__ void convert_weights(const Args& a, int l, bf16_t* Wb, LAS unsigned char* lds, int gw, int NGW, int wave, int lane) {
    LAS float* scr = (LAS float*)(lds + wave * 16384);
    constexpr int I_IN = 16 * 136, I_AO = 8 * 32, I_CO = 8 * 32, I_OUT = 16 * 32, I_UP = 16 * 128, I_DN = 64 * 32;
    constexpr int NITEMS = I_IN + I_AO + I_CO + I_OUT + I_UP + I_DN;
    const float* w_in = a.in[9] + (size_t)l * DM * IN_DIM; const float* w_ao = a.in[12] + (size_t)l * ATT * DM; const float* w_co = a.in[13] + (size_t)l * CD * DM;
    const float* w_out = a.in[14] + (size_t)l * DM * DM; const float* w_up = a.in[15] + (size_t)l * DM * FF; const float* w_dn = a.in[16] + (size_t)l * FF * DM;
    const float* g_pre = a.in[5] + l * DM; const float* g_mlp = a.in[7] + l * DM;
    for (int it = gw; it < NITEMS; it += NGW) {
        int r = it;
        if (r < I_IN) { transpose_item(w_in, g_pre, DM, IN_DIM, Wb + W_IN, 0, scr, r, lane); continue; } r -= I_IN;
        if (r < I_AO) { transpose_item(w_ao, nullptr, ATT, DM, Wb + W_BR, 0, scr, r, lane); continue; } r -= I_AO;
        if (r < I_CO) { transpose_item(w_co, nullptr, CD, DM, Wb + W_BR, 1024, scr, r, lane); continue; } r -= I_CO;
        if (r < I_OUT) { transpose_item(w_out, nullptr, DM, DM, Wb + W_OUT, 0, scr, r, lane); continue; } r -= I_OUT;
        if (r < I_UP) { transpose_item(w_up, g_mlp, DM, FF, Wb + W_UP, 0, scr, r, lane); continue; } r -= I_UP;
        transpose_item(w_dn, nullptr, FF, DM, Wb + W_DN, 0, scr, r, lane);
    }
}

__device__ __forceinline__ void rows_prologue(const float* xp, const float* xs, bf16_t* xb, float* r, int gw, int NGW, int lane) {
    for (int row = gw; row < M; row += NGW) {
        const float* xr = (row < MP) ? xp + (size_t)row * DM : xs + (size_t)(row - MP) * DM;
        f32x4 v[4]; float ss = 0.f;
#pragma unroll
        for (int j = 0; j < 4; ++j) { v[j] = *(const f32x4*)(xr + 4 * lane + 256 * j); ss += (v[j][0] * v[j][0] + v[j][1] * v[j][1]) + (v[j][2] * v[j][2] + v[j][3] * v[j][3]); }
        ss = wave_sum(ss);
#pragma unroll
        for (int j = 0; j < 4; ++j) { u32x2 w; w.x = pk2(v[j][0], v[j][1]); w.y = pk2(v[j][2], v[j][3]); *(u32x2*)(xb + (size_t)row * DM + 4 * lane + 256 * j) = w; }
        if (lane == 0) r[row] = 1.0f / sqrtf(ss * (1.0f / DM) + EPS);
    }
}
__device__ __forceinline__ void rows_residual(const bf16_t* src, const float* part, const float* xin_p, const float* xin_s, const float* g, float* xout, bf16_t* xb, float* r, int gw, int NGW, int lane) {
    f32x4 gv[4];
#pragma unroll
    for (int j = 0; j < 4; ++j) gv[j] = *(const f32x4*)(g + 4 * lane + 256 * j);
    for (int row = gw; row < M; row += NGW) {
        const float* xr = (row < MP) ? xin_p + (size_t)row * DM : xin_s + (size_t)(row - MP) * DM;
        f32x4 s[4], x[4]; float ss = 0.f;
#pragma unroll
        for (int j = 0; j < 4; ++j) { x[j] = *(const f32x4*)(xr + 4 * lane + 256 * j);
            if (row < MP) { const u32x2 w = *(const u32x2*)(src + (size_t)row * DM + 4 * lane + 256 * j);
                s[j][0] = bf2f(w.x & 0xffffu); s[j][1] = __uint_as_float(w.x & 0xffff0000u); s[j][2] = bf2f(w.y & 0xffffu); s[j][3] = __uint_as_float(w.y & 0xffff0000u); }
            else { const float* pp = part + (size_t)(row - MP) * DM + 4 * lane + 256 * j; s[j] = *(const f32x4*)pp;
#pragma unroll
                for (int q = 1; q < NSL; ++q) s[j] += *(const f32x4*)(pp + (size_t)q * MS * DM); }
            ss += (s[j][0] * s[j][0] + s[j][1] * s[j][1]) + (s[j][2] * s[j][2] + s[j][3] * s[j][3]); }
        ss = wave_sum(ss);
        const float rm = 1.0f / sqrtf(ss * (1.0f / DM) + EPS);
        float s2 = 0.f;
#pragma unroll
        for (int j = 0; j < 4; ++j) { x[j] = x[j] + s[j] * rm * gv[j]; s2 += (x[j][0] * x[j][0] + x[j][1] * x[j][1]) + (x[j][2] * x[j][2] + x[j][3] * x[j][3]); }
        s2 = wave_sum(s2);
#pragma unroll
        for (int j = 0; j < 4; ++j) { *(f32x4*)(xout + (size_t)row * DM + 4 * lane + 256 * j) = x[j];
            u32x2 w; w.x = pk2(x[j][0], x[j][1]); w.y = pk2(x[j][2], x[j][3]); *(u32x2*)(xb + (size_t)row * DM + 4 * lane + 256 * j) = w; }
        if (lane == 0) r[row] = 1.0f / sqrtf(s2 * (1.0f / DM) + EPS);
    }
}

constexpr int KS_STRIDE = 72, VT_STRIDE = 264;
constexpr int VT_OFF = 256 * KS_STRIDE * 2;
constexpr float SC_L2 = 0.125f * LOG2E;

template <bool SAMPLE>
__device__ __forceinline__ void attn_qtile(const LAS unsigned char* lds, const bf16_t* Z, bf16_t* AO, int qrow, int head, int iq, int tb, bool has_prev, float sink_l2, int lane) {
    const int q = lane & 15, g = lane >> 4;
    const bf16x8 qf0 = *(const bf16x8*)(Z + (size_t)qrow * ZP + ZQ + head * 64 + 8 * g);
    const bf16x8 qf1 = *(const bf16x8*)(Z + (size_t)qrow * ZP + ZQ + head * 64 + 32 + 8 * g);
    f32x4 s[10];
    const LAS unsigned char* kbase = lds + ((tb * 16 + q) * KS_STRIDE + 8 * g) * 2;
    const int lo1 = (!SAMPLE && !has_prev && iq < 127) ? 128 : iq + 1;
    const unsigned span = (unsigned)(iq + 128 - lo1);
    const int d0 = tb * 16 + 4 * g - lo1;
    float mx = sink_l2;
#pragma unroll
    for (int t = 0; t < 10; ++t) {
        const bf16x8 a0 = *(const LAS bf16x8*)(kbase + t * 16 * KS_STRIDE * 2);
        const bf16x8 a1 = *(const LAS bf16x8*)(kbase + t * 16 * KS_STRIDE * 2 + 64);
        f32x4 z = {0.f, 0.f, 0.f, 0.f};
        z = __builtin_amdgcn_mfma_f32_16x16x32_bf16(a0, qf0, z, 0, 0, 0);
        z = __builtin_amdgcn_mfma_f32_16x16x32_bf16(a1, qf1, z, 0, 0, 0);
#pragma unroll
        for (int j = 0; j < 4; ++j) {
            const bool vis = (unsigned)(d0 + t * 16 + j) <= span;
            const float v = vis ? z[j] * SC_L2 : -INFINITY;
            z[j] = v; mx = fmaxf(mx, v);
        }
        s[t] = z;
    }
    mx = fmaxf(mx, __shfl_xor(mx, 16)); mx = fmaxf(mx, __shfl_xor(mx, 32));
    float sum = 0.f;
#pragma unroll
    for (int t = 0; t < 10; ++t)
#pragma unroll
        for (int j = 0; j < 4; ++j) { const float p = __builtin_amdgcn_exp2f(s[t][j] - mx); s[t][j] = p; sum += p; }
    sum += __shfl_xor(sum, 16); sum += __shfl_xor(sum, 32);
    sum += __builtin_amdgcn_exp2f(sink_l2 - mx);
    const float inv = 1.0f / sum;
    bf16x8 pf[5];
#pragma unroll
    for (int c = 0; c < 5; ++c) {
        u32x4 w; w.x = pk2(s[2 * c][0] * inv, s[2 * c][1] * inv); w.y = pk2(s[2 * c][2] * inv, s[2 * c][3] * inv);
        w.z = pk2(s[2 * c + 1][0] * inv, s[2 * c + 1][1] * inv); w.w = pk2(s[2 * c + 1][2] * inv, s[2 * c + 1][3] * inv);
        pf[c] = __builtin_bit_cast(bf16x8, w);
    }
    f32x4 o[4];
#pragma unroll
    for (int dt = 0; dt < 4; ++dt) o[dt] = (f32x4){0.f, 0.f, 0.f, 0.f};
    const LAS unsigned char* vbase = lds + VT_OFF + (q * VT_STRIDE + tb * 16 + 4 * g) * 2;
#pragma unroll
    for (int c = 0; c < 5; ++c)
#pragma unroll
        for (int dt = 0; dt < 4; ++dt) {
            const u32x2 lo = *(const LAS u32x2*)(vbase + dt * 16 * VT_STRIDE * 2 + c * 64);
            const u32x2 hi = *(const LAS u32x2*)(vbase + dt * 16 * VT_STRIDE * 2 + c * 64 + 32);
            const u32x4 av = {lo.x, lo.y, hi.x, hi.y};
            o[dt] = __builtin_amdgcn_mfma_f32_16x16x32_bf16(__builtin_bit_cast(bf16x8, av), pf[c], o[dt], 0, 0, 0);
        }
#pragma unroll
    for (int dt = 0; dt < 4; ++dt) { u32x2 w; w.x = pk2(o[dt][0], o[dt][1]); w.y = pk2(o[dt][2], o[dt][3]);
        *(u32x2*)(AO + (size_t)qrow * ATT + head * 64 + dt * 16 + 4 * g) = w; }
}

__device__ __forceinline__ void lds_put_kv(LAS unsigned char* lds, int key, int ch, u32x4 kv, u32x4 vv) {
    *(LAS u32x4*)(lds + key * (KS_STRIDE * 2) + ch * 16) = kv;
    LAS unsigned short* vt = (LAS unsigned short*)(lds + VT_OFF) + (ch * 8) * VT_STRIDE + key;
    vt[0 * VT_STRIDE] = (unsigned short)(vv.x & 0xffffu); vt[1 * VT_STRIDE] = (unsigned short)(vv.x >> 16);
    vt[2 * VT_STRIDE] = (unsigned short)(vv.y & 0xffffu); vt[3 * VT_STRIDE] = (unsigned short)(vv.y >> 16);
    vt[4 * VT_STRIDE] = (unsigned short)(vv.z & 0xffffu); vt[5 * VT_STRIDE] = (unsigned short)(vv.z >> 16);
    vt[6 * VT_STRIDE] = (unsigned short)(vv.w & 0xffffu); vt[7 * VT_STRIDE] = (unsigned short)(vv.w >> 16);
}
__device__ __forceinline__ void store8f(float* dst, const u32x4 v) { float f[8]; unpack8(v, f); *(f32x4*)dst = (f32x4){f[0], f[1], f[2], f[3]}; *(f32x4*)(dst + 4) = (f32x4){f[4], f[5], f[6], f[7]}; }

__device__ __forceinline__ void attn_prompt_unit(const Args& a, int l, int unit, const bf16_t* Z, bf16_t* AO, LAS unsigned char* lds, int tid, int wave, int lane) {
    const int b = unit >> 5, qb = (unit >> 1) & 15, kvh = unit & 1;
    const int rowbase = b * SEQ + qb * 128;
    const bool has_prev = qb > 0;
#pragma unroll
    for (int i = 0; i < 4; ++i) {
        const int item = tid + NTHREADS * i, key = item >> 3, ch = item & 7;
        u32x4 kv = {0u, 0u, 0u, 0u}, vv = {0u, 0u, 0u, 0u};
        if (has_prev || key >= 128) {
            const bf16_t* zr = Z + (size_t)(rowbase - 128 + key) * ZP + kvh * 64 + ch * 8;
            kv = *(const u32x4*)(zr + ZK); vv = *(const u32x4*)(zr + ZV);
            if (qb == 15 && key >= 128) {
                const size_t o = (((size_t)(l * NBATCH + b) * 128 + (key - 128)) * 2 + kvh) * 64 + ch * 8;
                store8f(a.out + O_KP + o, kv); store8f(a.out + O_VP + o, vv);
            }
        }
        lds_put_kv(lds, key, ch, kv, vv);
    }
    __syncthreads();
    const int hh = wave >> 1, half = wave & 1, head = kvh * 4 + hh;
    const float sink_l2 = a.in[10][l * 8 + head] * LOG2E;
#pragma unroll 1
    for (int qt = 0; qt < 4; ++qt) {
        const int iq0 = half * 64 + qt * 16, iq = iq0 + (lane & 15);
        attn_qtile<false>(lds, Z, AO, rowbase + iq, head, iq, (iq0 >> 4) & ~1, has_prev, sink_l2, lane);
    }
    __syncthreads();
}
__device__ __forceinline__ void attn_sample_unit(const Args& a, int l, int unit, const bf16_t* Z, bf16_t* AO, LAS unsigned char* lds, int tid, int wave, int lane) {
    const int n = unit >> 1, kvh = unit & 1;
    const float* ck = a.in[2] + ((size_t)(l * DBATCH + n) * 128) * 128 + kvh * 64;
    const float* cv = a.in[3] + ((size_t)(l * DBATCH + n) * 128) * 128 + kvh * 64;
#pragma unroll
    for (int i = 0; i < 3; ++i) {
        const int item = tid + NTHREADS * i, key = item >> 3, ch = item & 7;
        if (item < 160 * 8) {
            u32x4 kv = {0u, 0u, 0u, 0u}, vv = {0u, 0u, 0u, 0u};
            const size_t o = (((size_t)(l * DBATCH + n) * 128 + (key - 8)) * 2 + kvh) * 64 + ch * 8;
            if (key < 128) {
                const f32x4 k0 = *(const f32x4*)(ck + (size_t)key * 128 + ch * 8), k1 = *(const f32x4*)(ck + (size_t)key * 128 + ch * 8 + 4);
                const f32x4 v0 = *(const f32x4*)(cv + (size_t)key * 128 + ch * 8), v1 = *(const f32x4*)(cv + (size_t)key * 128 + ch * 8 + 4);
                kv = (u32x4){pk2(k0[0], k0[1]), pk2(k0[2], k0[3]), pk2(k1[0], k1[1]), pk2(k1[2], k1[3])};
                vv = (u32x4){pk2(v0[0], v0[1]), pk2(v0[2], v0[3]), pk2(v1[0], v1[1]), pk2(v1[2], v1[3])};
                if (key >= 8) { *(f32x4*)(a.out + O_KS + o) = k0; *(f32x4*)(a.out + O_KS + o + 4) = k1; *(f32x4*)(a.out + O_VS + o) = v0; *(f32x4*)(a.out + O_VS + o + 4) = v1; }
            } else if (key < 136) {
                const bf16_t* zr = Z + (size_t)(MP + n * DSEQ + (key - 128)) * ZP + kvh * 64 + ch * 8;
                kv = *(const u32x4*)(zr + ZK); vv = *(const u32x4*)(zr + ZV);
                store8f(a.out + O_KS + o, kv); store8f(a.out + O_VS + o, vv);
            }
            lds_put_kv(lds, key, ch, kv, vv);
        }
    }
    __syncthreads();
    if (wave < 2) {
        const int q = lane & 15, head = kvh * 4 + wave * 2 + (q >> 3), t = q & 7;
        const float sink_l2 = a.in[10][l * 8 + head] * LOG2E;
        attn_qtile<true>(lds, Z, AO, MP + n * DSEQ + t, head, t, 0, true, sink_l2, lane);
    }
    __syncthreads();
}

__device__ __forceinline__ void conv_phase(const Args& a, int l, const bf16_t* Z, bf16_t* BZ, int gtid, int nth) {
    const float* cw = a.in[11] + (size_t)l * 3 * CD;
    for (int item = gtid; item < M * 64; item += nth) {
        const int row = item >> 6, c0 = (item & 63) * 8;
        const bool smp = row >= MP;
        const int t = smp ? ((row - MP) & 7) : (row & (SEQ - 1));
        const int n = smp ? ((row - MP) >> 3) : (row >> 11);
        const bf16_t* zr = Z + (size_t)row * ZP + c0;
        float Bv[8], Cv[8], Uv[8], u2[8], u1[8], u0[8];
        unpack8(*(const u32x4*)(zr + ZB), Bv); unpack8(*(const u32x4*)(zr + ZC), Cv); unpack8(*(const u32x4*)(zr + ZU), Uv);
#pragma unroll
        for (int e = 0; e < 8; ++e) u2[e] = Cv[e] * Uv[e];
        if (t >= 1) { unpack8(*(const u32x4*)(zr - ZP + ZC), Cv); unpack8(*(const u32x4*)(zr - ZP + ZU), Uv);
#pragma unroll
            for (int e = 0; e < 8; ++e) u1[e] = Cv[e] * Uv[e];
        } else if (smp) { const float* sp = a.in[4] + ((size_t)(l * DBATCH + n) * 2 + 1) * CD + c0;
#pragma unroll
            for (int e = 0; e < 8; ++e) u1[e] = sp[e];
        } else {
#pragma unroll
            for (int e = 0; e < 8; ++e) u1[e] = 0.f;
        }
        if (t >= 2) { unpack8(*(const u32x4*)(zr - 2 * ZP + ZC), Cv); unpack8(*(const u32x4*)(zr - 2 * ZP + ZU), Uv);
#pragma unroll
            for (int e = 0; e < 8; ++e) u0[e] = Cv[e] * Uv[e];
        } else if (smp) { const float* sp = a.in[4] + ((size_t)(l * DBATCH + n) * 2 + t) * CD + c0;
#pragma unroll
            for (int e = 0; e < 8; ++e) u0[e] = sp[e];
        } else {
#pragma unroll
            for (int e = 0; e < 8; ++e) u0[e] = 0.f;
        }
        float o[8];
#pragma unroll
        for (int e = 0; e < 8; ++e) o[e] = Bv[e] * (cw[c0 + e] * u0[e] + cw[CD + c0 + e] * u1[e] + cw[2 * CD + c0 + e] * u2[e]);
        *(u32x4*)(BZ + (size_t)row * CD + c0) = pack8(o);
        const int tl = smp ? DSEQ : SEQ;
        if (t >= tl - 2) {
            float* dst = smp ? a.out + O_CS + ((size_t)(l * DBATCH + n) * 2 + (t - (tl - 2))) * CD + c0 : a.out + O_CP + ((size_t)(l * NBATCH + n) * 2 + (t - (tl - 2))) * CD + c0;
            *(f32x4*)dst = (f32x4){u2[0], u2[1], u2[2], u2[3]}; *(f32x4*)(dst + 4) = (f32x4){u2[4], u2[5], u2[6], u2[7]};
        }
    }
}


#define RLX_AGENT __ATOMIC_RELAXED, __HIP_MEMORY_SCOPE_AGENT
#define XB_TMO      128
#define XB_XCNT(j)  (256  + 64 * (j))
#define XB_XSUB(j)  (1280 + 64 * (j))
#define XB_XGEN(j)  (2304 + 64 * (j))
#define XB_TOP      3328
#define XB_TOPGEN   3392
#define XCD_BAR_WORDS 3456
#define XB_SPIN_CAP (1u << 18)

__device__ __forceinline__ unsigned xb_ld(unsigned* p)              { return __hip_atomic_load(p, __ATOMIC_RELAXED, __HIP_MEMORY_SCOPE_AGENT); }
__device__ __forceinline__ unsigned xb_add(unsigned* p, unsigned v) { return __hip_atomic_fetch_add(p, v, __ATOMIC_RELAXED, __HIP_MEMORY_SCOPE_AGENT); }
__device__ __forceinline__ unsigned xb_xcc_id() { return (unsigned)__builtin_amdgcn_s_getreg((3 << 11) | 20) & 0xFu; }
#define XB_SPIN(cond, bar) do { unsigned _sp = 0; while (cond) { __builtin_amdgcn_s_sleep(1); \
    if ((++_sp & 255u) == 0u) { if (xb_ld(&(bar)[XB_TMO])) break; if (_sp > XB_SPIN_CAP) { atomicAdd(&(bar)[XB_TMO], 1u); break; } } } } while (0)

struct XcdBarrier {
    unsigned* bar; unsigned x;
    volatile LAS unsigned* st;
};

__device__ __forceinline__ XcdBarrier xcd_barrier_post(unsigned* bar, volatile LAS unsigned* st) {
    XcdBarrier b; b.bar = bar; b.x = xb_xcc_id(); b.st = st;
    if (threadIdx.x == 0) (void)xb_add(&bar[XB_XCNT(b.x)], 1u);
    return b;
}
__device__ __forceinline__ void xcd_barrier_complete(unsigned* bar, unsigned x, unsigned& nloc, unsigned& nx) {
    const unsigned G = gridDim.x * gridDim.y * gridDim.z;
    unsigned sum, cnt, mine, sp = 0u;
    for (;;) {
        sum = 0u; cnt = 0u; mine = 0u;
#pragma unroll
        for (unsigned j = 0; j < 16; ++j) { const unsigned c = xb_ld(&bar[XB_XCNT(j)]); sum += c; cnt += (c > 0u) ? 1u : 0u; mine = (j == x) ? c : mine; }
        if (sum == G) break;
        __builtin_amdgcn_s_sleep(1);
        if ((++sp & 255u) == 0u) { if (xb_ld(&bar[XB_TMO])) break; if (sp > XB_SPIN_CAP) { atomicAdd(&bar[XB_TMO], 1u); break; } }
    }
    nloc = mine > 0u ? mine : 1u; nx = cnt > 0u ? cnt : 1u;
}

__device__ __forceinline__ void xcd_barrier(const XcdBarrier& b) {
    asm volatile("s_waitcnt vmcnt(0)" ::: "memory");
    __syncthreads();
    if (threadIdx.x == 0) {
        unsigned* bar = b.bar;
        __builtin_amdgcn_s_waitcnt(0);
        unsigned nloc = b.st[0], nx = b.st[1];
        if (nloc == 0u) { xcd_barrier_complete(bar, b.x, nloc, nx); b.st[0] = nloc; b.st[1] = nx; }
        const unsigned old = xb_add(&bar[XB_XSUB(b.x)], 1u);
        const unsigned gen = old / nloc;
        if (old + 1u == (gen + 1u) * nloc) {
            __builtin_amdgcn_fence(__ATOMIC_RELEASE, "agent");
            asm volatile("s_waitcnt vmcnt(0)" ::: "memory");
            const unsigned og = xb_add(&bar[XB_TOP], 1u);
            const unsigned tg = og / nx;
            if (og + 1u == (tg + 1u) * nx) xb_add(&bar[XB_TOPGEN], 1u);
            else XB_SPIN(xb_ld(&bar[XB_TOPGEN]) == tg, bar);
            __builtin_amdgcn_fence(__ATOMIC_ACQUIRE, "agent");
            xb_add(&bar[XB_XGEN(b.x)], 1u);
            asm volatile("s_waitcnt vmcnt(0)" ::: "memory");
        } else {
            XB_SPIN(xb_ld(&bar[XB_XGEN(b.x)]) == gen, bar);
            __builtin_amdgcn_fence(__ATOMIC_ACQUIRE, "agent");
            asm volatile("s_waitcnt vmcnt(0)" ::: "memory");
        }
    }
    __syncthreads();
}
__device__ __forceinline__ Args fresh_args() {
#if defined(__HIP_DEVICE_COMPILE__)
    const CAS unsigned long long* p = (const CAS unsigned long long*)__builtin_amdgcn_kernarg_segment_ptr(); asm volatile("" : "+s"(p));
    Args a;
#pragma unroll
    for (int i = 0; i < 17; ++i) a.in[i] = (const float*)p[i];
    a.out = (float*)p[17]; a.ws = (unsigned char*)p[18];
    return a;
#else
    return Args{};
#endif
}
__global__ void __launch_bounds__(NTHREADS, 2) fwd_megakernel(Args a_unused) {
    extern __shared__ __attribute__((aligned(16))) unsigned char lds_raw[];
    LAS unsigned char* lds = (LAS unsigned char*)lds_raw;
    cg::grid_group grid = cg::this_grid();
    const int G = gridDim.x, bx = blockIdx.x, NGW = G * NWAVES;
#define FRESH() int tid = threadIdx.x; asm volatile("" : "+v"(tid)); const int lane = tid & 63, wave = __builtin_amdgcn_readfirstlane(tid >> 6), gw = bx * NWAVES + wave; (void)lane; (void)gw
#define PTRS() const Args a = fresh_args(); unsigned char* ws = a.ws; \
    float* R = (float*)(ws + WS_R); bf16_t* Wb = (bf16_t*)(ws + WS_W); bf16_t* Z = (bf16_t*)(ws + WS_Z); bf16_t* S1 = (bf16_t*)(ws + WS_S1); bf16_t* S2 = (bf16_t*)(ws + WS_S2); float* Y = a.out + O_Y; \
    (void)R; (void)Wb; (void)Z; (void)S1; (void)S2; (void)Y

    volatile LAS unsigned* bst = (volatile LAS unsigned*)(lds + 131072 + 64);
    { FRESH(); PTRS(); unsigned* barw = (unsigned*)(ws + WS_BAR);
      if (tid < 2) bst[tid] = 0u;
      if (bx == 0) for (int i = tid; i < XCD_BAR_WORDS; i += NTHREADS) __hip_atomic_store(barw + i, 0u, RLX_AGENT);
      convert_weights(a, 0, Wb, lds, gw, NGW, wave, lane);
      rows_prologue(a.in[0], a.in[1], S2, R, gw, NGW, lane); }
    grid.sync();
    XcdBarrier xbar;
    { PTRS(); xbar = xcd_barrier_post((unsigned*)(ws + WS_BAR), bst); }
#define GSYNC() do { XcdBarrier xb_ = xbar; asm volatile("" : "+s"(xb_.bar), "+s"(xb_.x)); xcd_barrier(xb_); } while (0)
#ifndef PHM
#define PHM 0xff
#endif

#pragma unroll 1
    for (int l = 0; l < DEPTH; ++l) {
        if (PHM & 1) {
            PTRS();
            pg8::Gemm g{l == 0 ? S2 : S1, Wb + W_IN, M, IN_DIM, DM}; pg8::StaticOrder S; S.init(M, IN_DIM, G, bx);
            Epi<1> E{Z, ZP, R, Z, nullptr};
            pg8::gemm_phase<Epi<1>, pg8::StaticOrder, true, true>(lds, g, S, E);
        }
        GSYNC();
        if (PHM & 2) {
            FRESH(); PTRS();
            for (int u = bx; u < NBATCH * 16 * 2; u += G) attn_prompt_unit(a, l, u, Z, S1, lds, tid, wave, lane);
            for (int u = bx; u < DBATCH * 2; u += G) attn_sample_unit(a, l, u, Z, S1, lds, tid, wave, lane);
            conv_phase(a, l, Z, S1 + (size_t)M * ATT, bx * NTHREADS + tid, G * NTHREADS);
        }
        GSYNC();
        if (PHM & 4) {
            PTRS();
            pg8::Gemm g{S1, Wb + W_BR, 2 * M, 2048, 512}; PairOrder S; S.init(G, bx);
            Epi<3> E{S2, DM, R, Z, nullptr};
            pg8::gemm_phase<Epi<3>, PairOrder, true, true>(lds, g, S, E);
        }
        GSYNC();
        if (PHM & 8) {
            PTRS();
            pg8::Gemm g{S2, Wb + W_OUT, M, DM, DM}; SliceOrder S; S.init(G, bx, 32 / NSL, 16);
            Epi<4> E{S1, DM, R, Z, (float*)Z};
            pg8::gemm_phase<Epi<4>, SliceOrder, true, true>(lds, g, S, E);
        }
        GSYNC();
        { FRESH(); PTRS(); rows_residual(S1, (const float*)Z, l == 0 ? a.in[0] : Y, l == 0 ? a.in[1] : Y + (size_t)MP * DM, a.in[6] + l * DM, Y, S2, R, gw, NGW, lane); }
        GSYNC();
        if (PHM & 16) {
            PTRS();
            pg8::Gemm g{S2, Wb + W_UP, M, FF, DM}; pg8::StaticOrder S; S.init(M, FF, G, bx);
            Epi<6> E{Z, FF, R, Z, nullptr};
            pg8::gemm_phase<Epi<6>, pg8::StaticOrder, true, true>(lds, g, S, E);
        }
        GSYNC();
        if (PHM & 32) {
            PTRS();
            pg8::Gemm g{Z, Wb + W_DN, M, DM, FF}; SliceOrder S; S.init(G, bx, 64 / NSL, 64);
            Epi<4> E{S1, DM, R, Z, (float*)S2};
            pg8::gemm_phase<Epi<4>, SliceOrder, true, true>(lds, g, S, E);
        }
        GSYNC();
        { FRESH(); PTRS(); rows_residual(S1, (const float*)S2, Y, Y + (size_t)MP * DM, a.in[8] + l * DM, Y, S1, R, gw, NGW, lane);
          if (l + 1 < DEPTH) convert_weights(a, l + 1, Wb, lds, gw, NGW, wave, lane); }
        if (l + 1 < DEPTH) GSYNC();
    }
}

extern "C" void kernel_launch(void* const* d_in, const int* in_sizes, int n_in, void* d_out, int out_size, void* d_ws, size_t ws_size, hipStream_t stream) {
    static int grid = 0;
    if (grid == 0) {
        if (n_in != 17 || ws_size < WS_END) { fprintf(stderr, "kernel_launch: unexpected n_in %d / ws_size %zu (need %zu)\n", n_in, ws_size, (size_t)WS_END); grid = -1; return; }
        int dev = 0, cus = 0, per_cu = 0;
        hipGetDevice(&dev);
        hipDeviceGetAttribute(&cus, hipDeviceAttributeMultiprocessorCount, dev);
        if (hipFuncSetAttribute((const void*)fwd_megakernel, hipFuncAttributeMaxDynamicSharedMemorySize, LDS_BYTES) != hipSuccess) fprintf(stderr, "kernel_launch: hipFuncSetAttribute failed\n");
        if (hipOccupancyMaxActiveBlocksPerMultiprocessor(&per_cu, (const void*)fwd_megakernel, NTHREADS, LDS_BYTES) != hipSuccess || per_cu < 1) { fprintf(stderr, "kernel_launch: occupancy query gave %d\n", per_cu); per_cu = 1; }
        (void)hipGetLastError();
        grid = cus * per_cu;
    }
    if (grid < 0) return;
    Args a{};
    for (int i = 0; i < 17; ++i) a.in[i] = (const float*)d_in[i];
    a.out = (float*)d_out; a.ws = (unsigned char*)d_ws;
    void* args[] = {&a};
    hipError_t e = hipLaunchCooperativeKernel((const void*)fwd_megakernel, dim3(grid), dim3(NTHREADS), args, LDS_BYTES, stream);
    if (e != hipSuccess) fprintf(stderr, "cooperative launch failed: %s (grid %d)\n", hipGetErrorString(e), grid);
}
```

```cpp
#include <hip/hip_runtime.h>
#include <hip/hip_cooperative_groups.h>
#include <cstdio>
#include <cstdint>
namespace cg = cooperative_groups;
namespace pg8 {
#define PG8_LAS __attribute__((address_space(3)))
typedef unsigned short bf16_t;
typedef short bf16x8 __attribute__((ext_vector_type(8)));
typedef float f32x4 __attribute__((ext_vector_type(4)));
typedef unsigned u32x4 __attribute__((ext_vector_type(4)));
constexpr int BM = 256, BK = 64, HALF = 128, HTB = HALF * BK * 2  , STAGE_BYTES = 8 * HTB, NXCD = 8, WGM = 8;

__host__ __device__ __forceinline__ int lds_byte(int r, int c) { const int st = (r >> 4) * 2 + (c >> 5), rr = r & 15, cc = c & 31, ob = rr * 64 + cc * 2; return st * 1024 + (ob ^ (((ob >> 9) & 1) << 5)); }
__host__ __device__ __forceinline__ void stage_rc(int b, int& R, int& C) { const int st = b / 1024, sb = b % 1024, swz = sb ^ (((sb >> 9) & 1) << 5); R = (st >> 1) * 16 + swz / 64; C = (st & 1) * 32 + (swz % 64) / 2; }
__host__ __device__ __forceinline__ int perm32(int rho) { const int n = rho >> 4, i = rho & 15; return 8 * (i >> 2) + 4 * n + (i & 3); }

struct Unit { int pm, pn, pa, pb, w, koff, nt; };
struct Gemm { const bf16_t* A; const bf16_t* Bt; int M, N, K; };

struct StaticOrder {
    int nM, nN, nwg, G, c;
    __host__ __device__ __forceinline__ void init(int M, int N, int G_, int c_) { nM = M / BM; nN = N / BM; nwg = nM * nN; G = G_; c = c_; }
    __host__ __device__ __forceinline__ bool next(int i, Unit& u) const {
        const long L = (long)i * G + c; if (L >= nwg) return false;
        int wgid = (int)L; { const int q = nwg / NXCD, r = nwg % NXCD, xcd = wgid % NXCD, off = wgid / NXCD; wgid = (xcd < r ? xcd * (q + 1) : r * (q + 1) + (xcd - r) * q) + off; }
        const int nig = WGM * nN, gid = wgid / nig, fm = gid * WGM, gsz = (nM - fm) < WGM ? (nM - fm) : WGM;
        u.pm = fm + ((wgid % nig) % gsz); u.pn = (wgid % nig) / gsz; u.pa = u.pm; u.pb = u.pn; u.w = 0; u.koff = 0; u.nt = 0; return true;
    }
    __device__ __forceinline__ void a_ready(const Unit&) const {}
    __device__ __forceinline__ void done(const Unit&) const {}
};
__device__ __forceinline__ unsigned cvt_pk_bf16(float lo, float hi) { unsigned r; asm volatile("v_cvt_pk_bf16_f32 %0, %1, %2" : "=v"(r) : "v"(lo), "v"(hi)); return r; }
template <class Epi, class Sched, bool ALIGN_EPI = false, bool SP2 = false>
__device__ __forceinline__ void gemm_phase(PG8_LAS unsigned char* lds, const Gemm g, const Sched& S, const Epi& E) {
    int tid_ = threadIdx.x; asm volatile("" : "+v"(tid_));
    const int tid = tid_, wid = __builtin_amdgcn_readfirstlane(tid >> 6), lane = tid & 63, wr = wid >> 2, wc = wid & 3, fr = lane & 15, fq = lane >> 4;
    const int K = g.K, nt = K / BK;
    unsigned voffA[2], voffB[2];
#pragma unroll
    for (int i = 0; i < 2; ++i) { int R, C; stage_rc(tid * 16 + i * 8192, R, C); const int Rb = Epi::PERM ? ((R & ~31) + perm32(R & 31)) : R;
        voffA[i] = (unsigned)(R * K + C) * 2u; voffB[i] = (unsigned)(Rb * K + C) * 2u; }
    const size_t kstep = (size_t)(BK * 2);
    const size_t hstep = (size_t)HALF * K * 2;
    const size_t tstep = 2 * hstep;
    const unsigned ldsw = (unsigned)wid * 1024u;
    const int aoff = lds_byte(wr * 64 + fr, fq * 8), boff = lds_byte(wc * 32 + fr, fq * 8);
#define PG8_SA(b, h) (((b) * 2 + (h)) * HTB)
#define PG8_SB(b, h) ((4 + (b) * 2 + (h)) * HTB)
#define PG8_STAGE(bufoff, gbase, voff) do { _Pragma("unroll") for (int _i = 0; _i < 2; ++_i) \
        __builtin_amdgcn_global_load_lds((const unsigned*)((const char*)(gbase) + (voff)[_i]), (PG8_LAS unsigned*)(lds + (bufoff) + ldsw + _i * 8192), 16, 0, 0); } while (0)
#define PG8_LDA(dst, b, h) do { _Pragma("unroll") for (int m = 0; m < 4; ++m) _Pragma("unroll") for (int k = 0; k < 2; ++k) dst[m][k] = *(const PG8_LAS bf16x8*)(lds + PG8_SA(b, h) + aoff + m * 2048 + k * 1024); } while (0)
#define PG8_LDB(dst, b, h) do { _Pragma("unroll") for (int n = 0; n < 2; ++n) _Pragma("unroll") for (int k = 0; k < 2; ++k) dst[n][k] = *(const PG8_LAS bf16x8*)(lds + PG8_SB(b, h) + boff + n * 2048 + k * 1024); } while (0)
#define PG8_MMA(ai, bj, At, Bt) do { __builtin_amdgcn_s_setprio(1); _Pragma("unroll") for (int m = 0; m < 4; ++m) _Pragma("unroll") for (int n = 0; n < 2; ++n) _Pragma("unroll") for (int k = 0; k < 2; ++k) \
        acc[ai][bj][m][n] = __builtin_amdgcn_mfma_f32_16x16x32_bf16(Bt[n][k], At[m][k], acc[ai][bj][m][n], 0, 0, 0); __builtin_amdgcn_s_setprio(0); } while (0)
#define PG8_WAIT_V(n) asm volatile("s_waitcnt vmcnt(" #n ")" ::: "memory")
#define PG8_WAIT_L(n) asm volatile("s_waitcnt lgkmcnt(" #n ")" ::: "memory")
#define PG8_BAR __builtin_amdgcn_s_barrier()
#define PG8_SCHED __builtin_amdgcn_sched_barrier(0)
    Unit cur, nxt; int ui = 0;
    if (!S.next(0, cur)) return;
    f32x4 acc[2][2][4][2];
#pragma unroll
    for (int a = 0; a < 2; ++a)
#pragma unroll
        for (int b = 0; b < 2; ++b)
#pragma unroll
            for (int m = 0; m < 4; ++m)
#pragma unroll
                for (int n = 0; n < 2; ++n) acc[a][b][m][n] = (f32x4){0.f, 0.f, 0.f, 0.f};
    bf16x8 At[4][2], B0[2][2], B1[2][2];
    const char* cA = (const char*)g.A + (size_t)cur.pa * tstep + cur.koff; const char* cB = (const char*)g.Bt + (size_t)cur.pb * tstep + cur.koff;
    S.a_ready(cur);
    if constexpr (SP2) {
        PG8_STAGE(PG8_SB(0, 0), cB, voffB); PG8_STAGE(PG8_SB(0, 1), cB + hstep, voffB); PG8_STAGE(PG8_SA(0, 0), cA, voffA); PG8_STAGE(PG8_SA(0, 1), cA + hstep, voffA);
        if (wr == 1) PG8_BAR;
        PG8_WAIT_V(2); PG8_BAR;
        PG8_STAGE(PG8_SB(1, 0), cB + kstep, voffB); PG8_STAGE(PG8_SA(1, 0), cA + kstep, voffA); PG8_STAGE(PG8_SB(1, 1), cB + hstep + kstep, voffB);
        PG8_WAIT_V(6); PG8_BAR;
    } else {
        PG8_STAGE(PG8_SB(0, 0), cB, voffB); PG8_STAGE(PG8_SA(0, 0), cA, voffA); PG8_STAGE(PG8_SB(0, 1), cB + hstep, voffB); PG8_STAGE(PG8_SA(0, 1), cA + hstep, voffA);
        if (wr == 1) PG8_BAR;
        PG8_WAIT_V(4); PG8_BAR;
        PG8_STAGE(PG8_SB(1, 0), cB + kstep, voffB); PG8_STAGE(PG8_SA(1, 0), cA + kstep, voffA); PG8_STAGE(PG8_SB(1, 1), cB + hstep + kstep, voffB);
        PG8_WAIT_V(6); PG8_BAR;
    }
    for (;;) {
        const bool has_next = S.next(ui + 1, nxt);
        const char* nA = has_next ? (const char*)g.A + (size_t)nxt.pa * tstep + nxt.koff : cA; const char* nB = has_next ? (const char*)g.Bt + (size_t)nxt.pb * tstep + nxt.koff : cB;
        const int unt = cur.nt ? cur.nt : nt;
        for (int t = 0; t < unt; t += 2) {
            const bool last = (t == unt - 2);
            const char* a1 = cA + (size_t)(t + 1) * kstep;
            const char* a2 = last ? nA : cA + (size_t)(t + 2) * kstep; const char* b2 = last ? nB : cB + (size_t)(t + 2) * kstep;
            const char* a3 = a2 + kstep; const char* b3 = b2 + kstep;
            if (last && has_next) S.a_ready(nxt);
            if constexpr (SP2) {
            PG8_LDB(B0, 0, 0); PG8_LDB(B1, 0, 1); PG8_SCHED; PG8_LDA(At, 0, 0); PG8_STAGE(PG8_SA(1, 1), a1 + hstep, voffA);
            PG8_WAIT_V(8); PG8_WAIT_L(0); PG8_BAR; PG8_MMA(0, 0, At, B0); PG8_MMA(0, 1, At, B1); PG8_BAR; PG8_SCHED;
            PG8_LDA(At, 0, 1); PG8_STAGE(PG8_SB(0, 0), b2, voffB); PG8_STAGE(PG8_SB(0, 1), b2 + hstep, voffB); PG8_STAGE(PG8_SA(0, 0), a2, voffA);
            PG8_WAIT_V(8); PG8_WAIT_L(0); PG8_BAR; PG8_MMA(1, 0, At, B0); PG8_MMA(1, 1, At, B1); PG8_BAR; PG8_SCHED;
            PG8_LDB(B0, 1, 0); PG8_LDB(B1, 1, 1); PG8_SCHED; PG8_LDA(At, 1, 0); PG8_STAGE(PG8_SA(0, 1), a2 + hstep, voffA);
            PG8_WAIT_V(8); PG8_WAIT_L(0); PG8_BAR; PG8_MMA(0, 0, At, B0); PG8_MMA(0, 1, At, B1); PG8_BAR; PG8_SCHED;
            PG8_LDA(At, 1, 1); PG8_STAGE(PG8_SB(1, 0), b3, voffB); PG8_STAGE(PG8_SB(1, 1), b3 + hstep, voffB); PG8_STAGE(PG8_SA(1, 0), a3, voffA);
            PG8_WAIT_V(8); PG8_WAIT_L(0); PG8_BAR; PG8_MMA(1, 0, At, B0); PG8_MMA(1, 1, At, B1); PG8_BAR; PG8_SCHED;
            } else {
            PG8_LDB(B0, 0, 0); PG8_SCHED; PG8_LDA(At, 0, 0); PG8_STAGE(PG8_SA(1, 1), a1 + hstep, voffA);
            PG8_WAIT_L(8); PG8_BAR; PG8_WAIT_L(0); PG8_MMA(0, 0, At, B0); PG8_BAR; PG8_SCHED;
            PG8_LDB(B1, 0, 1); PG8_STAGE(PG8_SB(0, 0), b2, voffB);
            PG8_BAR; PG8_WAIT_L(0); PG8_MMA(0, 1, At, B1); PG8_BAR;
            PG8_LDA(At, 0, 1); PG8_STAGE(PG8_SA(0, 0), a2, voffA);
            PG8_BAR; PG8_WAIT_L(0); PG8_MMA(1, 0, At, B0); PG8_BAR; PG8_SCHED;
            PG8_STAGE(PG8_SB(0, 1), b2 + hstep, voffB);
            PG8_WAIT_V(6); PG8_BAR; PG8_MMA(1, 1, At, B1); PG8_BAR;
            PG8_LDB(B0, 1, 0); PG8_SCHED; PG8_LDA(At, 1, 0); PG8_STAGE(PG8_SA(0, 1), a2 + hstep, voffA);
            PG8_WAIT_L(8); PG8_BAR; PG8_WAIT_L(0); PG8_MMA(0, 0, At, B0); PG8_BAR; PG8_SCHED;
            PG8_LDB(B1, 1, 1); PG8_STAGE(PG8_SB(1, 0), b3, voffB);
            PG8_BAR; PG8_WAIT_L(0); PG8_MMA(0, 1, At, B1); PG8_BAR;
            PG8_LDA(At, 1, 1); PG8_STAGE(PG8_SA(1, 0), a3, voffA);
            PG8_BAR; PG8_WAIT_L(0); PG8_MMA(1, 0, At, B0); PG8_BAR; PG8_SCHED;
            PG8_STAGE(PG8_SB(1, 1), b3 + hstep, voffB);
            PG8_WAIT_V(6); PG8_BAR; PG8_MMA(1, 1, At, B1); PG8_BAR;
            }
        }
        if constexpr (ALIGN_EPI) { if (wr == 0) PG8_BAR; }
        if constexpr (!Epi::AFTER_DRAIN) { E(acc, cur, wr, wc, fr, fq); S.done(cur); }
        if (!has_next) break;
#pragma unroll
        for (int a = 0; a < 2; ++a)
#pragma unroll
            for (int b = 0; b < 2; ++b)
#pragma unroll
                for (int m = 0; m < 4; ++m)
#pragma unroll
                    for (int n = 0; n < 2; ++n) acc[a][b][m][n] = (f32x4){0.f, 0.f, 0.f, 0.f};
        cur = nxt; cA = nA; cB = nB; ++ui;
        if constexpr (ALIGN_EPI) { if (wr == 1) PG8_BAR; }
    }
    PG8_WAIT_V(0);
    if constexpr (!ALIGN_EPI) { if (wr == 0) PG8_BAR; }
    PG8_BAR;
    if constexpr (Epi::AFTER_DRAIN) { E.fused(acc, cur, wr, wc, fr, fq, lds, wid, lane); S.done(cur); }
#undef PG8_SA
#undef PG8_SB
#undef PG8_STAGE
#undef PG8_LDA
#undef PG8_LDB
#undef PG8_MMA
#undef PG8_WAIT_V
#undef PG8_WAIT_L
#undef PG8_BAR
#undef PG8_SCHED
}
}
#ifndef REPMASK
#define REPMASK 0
#endif
#define LAS __attribute__((address_space(3)))
#define CAS __attribute__((address_space(4)))
typedef unsigned short bf16_t;
typedef short bf16x8 __attribute__((ext_vector_type(8)));
typedef float f32x4 __attribute__((ext_vector_type(4)));
typedef unsigned u32x4 __attribute__((ext_vector_type(4)));
typedef unsigned u32x2 __attribute__((ext_vector_type(2)));

constexpr int DM = 1024, NBATCH = 8, SEQ = 2048, DEPTH = 2, DBATCH = 128, DSEQ = 8;
constexpr int MP = NBATCH * SEQ, MS = DBATCH * DSEQ, M = MP + MS;
constexpr int IN_DIM = 4352, ATT = 512, CD = 512, FF = 4096;
constexpr int ZP = IN_DIM;
constexpr int ZQ = 0, ZK = 512, ZV = 640, ZB = 768, ZC = 1280, ZU = 1792, ZGA = 2304;
constexpr float EPS = 1e-6f;
constexpr float LOG2E = 1.4426950408889634f;

constexpr size_t O_Y = 0;
constexpr size_t O_KP = (size_t)M * DM;
constexpr size_t O_VP = O_KP + 2 * 8 * 128 * 128;
constexpr size_t O_CP = O_VP + 2 * 8 * 128 * 128;
constexpr size_t O_KS = O_CP + 2 * 8 * 2 * 512;
constexpr size_t O_VS = O_KS + (size_t)2 * 128 * 128 * 128;
constexpr size_t O_CS = O_VS + (size_t)2 * 128 * 128 * 128;

constexpr size_t MiB = 1u << 20;
constexpr size_t WS_R = 0;
constexpr size_t WS_BAR = 512 * 1024;
constexpr size_t WS_W = 3 * MiB;
constexpr size_t W_IN = 0, W_BR = W_IN + (size_t)IN_DIM * DM, W_OUT = W_BR + (size_t)2048 * 512, W_UP = W_OUT + (size_t)DM * DM, W_DN = W_UP + (size_t)FF * DM, W_END = W_DN + (size_t)DM * FF;
constexpr size_t WS_Z = 32 * MiB;
constexpr size_t WS_S1 = 177 * MiB;
constexpr size_t WS_S2 = 211 * MiB;
constexpr size_t WS_END = 247 * MiB;
constexpr int NSL = 8;
static_assert(WS_W + W_END * 2 <= WS_Z && WS_Z + (size_t)M * ZP * 2 <= WS_S1 && WS_S1 + (size_t)M * DM * 2 <= WS_S2 && WS_S2 + (size_t)(M + 1024) * DM * 2 <= WS_END, "ws map");

constexpr int LDS_BYTES = 147456;
constexpr int NTHREADS = 512, NWAVES = 8;

__device__ __forceinline__ float bf2f(unsigned b) { return __uint_as_float(b << 16); }
typedef float f32x2_t __attribute__((ext_vector_type(2))); typedef __bf16 bf16x2_t __attribute__((ext_vector_type(2)));
__device__ __forceinline__ unsigned pk2(float lo, float hi) { const f32x2_t v = {lo, hi}; const bf16x2_t b = __builtin_convertvector(v, bf16x2_t); return __builtin_bit_cast(unsigned, b); }
__device__ __forceinline__ float wave_sum(float v) {
#pragma unroll
    for (int o = 1; o < 64; o <<= 1) v += __shfl_xor(v, o);
    return v;
}
__device__ __forceinline__ void unpack8(const u32x4 v, float (&f)[8]) {
    f[0] = bf2f(v.x & 0xffffu); f[1] = __uint_as_float(v.x & 0xffff0000u); f[2] = bf2f(v.y & 0xffffu); f[3] = __uint_as_float(v.y & 0xffff0000u);
    f[4] = bf2f(v.z & 0xffffu); f[5] = __uint_as_float(v.z & 0xffff0000u); f[6] = bf2f(v.w & 0xffffu); f[7] = __uint_as_float(v.w & 0xffff0000u);
}
__device__ __forceinline__ u32x4 pack8(const float (&f)[8]) { u32x4 w; w.x = pk2(f[0], f[1]); w.y = pk2(f[2], f[3]); w.z = pk2(f[4], f[5]); w.w = pk2(f[6], f[7]); return w; }
__device__ __forceinline__ float sigmoidf_fast(float x) { return __builtin_amdgcn_rcpf(1.0f + __builtin_amdgcn_exp2f(-x * LOG2E)); }

template <int MODE> struct Epi {
    static constexpr bool PERM = true, AFTER_DRAIN = false;
    bf16_t* O; int ldc; const float* r; const bf16_t* Z; float* part;
    __device__ __forceinline__ void operator()(const f32x4 (&acc)[2][2][4][2], const pg8::Unit& u, int wr, int wc, int fr, int fq) const {
        const int row0 = u.pm * 256 + wr * 64 + fr, col0 = u.pn * 256 + wc * 32 + 8 * fq;
#pragma unroll
        for (int ai = 0; ai < 2; ++ai)
#pragma unroll
            for (int m = 0; m < 4; ++m) {
                const int row = row0 + ai * 128 + m * 16;
                float rs = 1.f;
                if (MODE == 1 || MODE == 6) rs = r[row];
#pragma unroll
                for (int bj = 0; bj < 2; ++bj) {
                    const int col = col0 + bj * 128;
                    const f32x4 a0 = acc[ai][bj][m][0], a1 = acc[ai][bj][m][1];
                    float v[8] = {a0[0], a0[1], a0[2], a0[3], a1[0], a1[1], a1[2], a1[3]};
                    if (MODE == 4 && u.pm >= MP / 256) {
                        float* pd = part + ((size_t)u.w * MS + (row - MP)) * DM + col;
                        *(f32x4*)pd = a0; *(f32x4*)(pd + 4) = a1; continue; }
                    bf16_t* dst = O + (size_t)(row + ((MODE == 3 && u.pm >= MP / 256) ? u.w * MS : 0)) * ldc + col;
                    if (MODE == 1) {
#pragma unroll
                        for (int e = 0; e < 8; ++e) v[e] *= rs;
                        if (u.pn >= 9) {
#pragma unroll
                            for (int e = 0; e < 8; ++e) v[e] = sigmoidf_fast(v[e]);
                        }
                    } else if (MODE == 3) {
                        float gt[8]; unpack8(*(const u32x4*)(Z + (size_t)row * ZP + ZGA + u.w * 1024 + col), gt);
#pragma unroll
                        for (int e = 0; e < 8; ++e) v[e] *= gt[e];
                        if (u.w == 1 && u.pm < MP / 256) { float t[8]; unpack8(*(const u32x4*)dst, t);
#pragma unroll
                            for (int e = 0; e < 8; ++e) v[e] += t[e]; }
                    } else if (MODE == 6) {
#pragma unroll
                        for (int e = 0; e < 8; ++e) { const float q = fmaxf(v[e] * rs, 0.f); v[e] = q * q; }
                    }
                    *(u32x4*)dst = pack8(v);
                }
            }
    }
};

struct PairOrder {
    pg8::StaticOrder so; int c;
    __device__ __forceinline__ void init(int G_, int c_) { so.init(MP, DM, G_, c_); c = c_; }
    __device__ __forceinline__ bool next(int i, pg8::Unit& u) const {
        const int np = (so.nwg - c + so.G - 1) / so.G;
        pg8::Unit t; t.pm = 0; t.pn = 0; t.pa = 0; t.pb = 0; t.w = 0; t.koff = 0; t.nt = 0;
        bool ok;
        if (i < 2 * np) { ok = so.next(i >> 1, t); t.w = i & 1; }
        else { const int j = (i - 2 * np) * so.G + c; ok = j < 32; t.pm = MP / 256 + ((j >> 3) & 3); t.pn = (j >> 1) & 3; t.w = j & 1; }
        t.koff = 0; t.nt = 0; t.pa = t.w * (M / 256) + t.pm; t.pb = t.w * 4 + t.pn; u = t; return ok; }
    __device__ __forceinline__ void a_ready(const pg8::Unit&) const {}
    __device__ __forceinline__ void done(const pg8::Unit&) const {}
};
struct SliceOrder {
    pg8::StaticOrder so; int c, ntl, wrapk;
    __device__ __forceinline__ void init(int G_, int c_, int ntl_, int wrapk_) { so.init(MP, DM, G_, c_); c = c_; ntl = ntl_; wrapk = wrapk_; }
    __device__ __forceinline__ bool next(int i, pg8::Unit& u) const {
        const int nsl = (c < 16 * NSL) ? (16 * NSL - c + so.G - 1) / so.G : 0;
        pg8::Unit t; t.pm = 0; t.pn = 0; t.pa = 0; t.pb = 0; t.w = 0; t.koff = 0; t.nt = 0;
        bool ok;
        if (i < nsl) { const int j = i * so.G + c, tile = j / NSL, s = j % NSL, kt0 = s * ntl, src = kt0 / wrapk; ok = true;
            t.pm = MP / 256 + (tile >> 2); t.pn = tile & 3; t.w = s; t.pa = MP / 256 + src * 4 + (tile >> 2); t.pb = t.pn; t.koff = (kt0 % wrapk) * 128; t.nt = ntl; }
        else ok = so.next(i - nsl, t);
        u = t; return ok; }
    __device__ __forceinline__ void a_ready(const pg8::Unit&) const {}
    __device__ __forceinline__ void done(const pg8::Unit&) const {}
};

__device__ __forceinline__ void transpose_item(const float* W, const float* gk, int K, int N, bf16_t* WT, int row_off, LAS float* scr, int item, int lane) {
    const int nblk = N / 32, kb = item / nblk, nb = item % nblk, k0 = 64 * kb, n0 = 32 * nb;
    float wv[32];
#pragma unroll
    for (int i = 0; i < 32; ++i) { const int kk = 2 * i + (lane >> 5); wv[i] = W[(size_t)(k0 + kk) * N + n0 + (lane & 31)]; }
    if (gk) {
#pragma unroll
        for (int i = 0; i < 32; ++i) wv[i] *= gk[k0 + 2 * i + (lane >> 5)];
    }
#pragma unroll
    for (int i = 0; i < 32; ++i) { const int kk = 2 * i + (lane >> 5); scr[kk * 33 + (lane & 31)] = wv[i]; }
    asm volatile("s_waitcnt lgkmcnt(0)" ::: "memory");
    const int c = lane & 7;
#pragma unroll
    for (int j = 0; j < 4; ++j) { const int n = (lane >> 3) + 8 * j; const LAS float* s = scr + (8 * c) * 33 + n;
        u32x4 o; o.x = pk2(s[0 * 33], s[1 * 33]); o.y = pk2(s[2 * 33], s[3 * 33]); o.z = pk2(s[4 * 33], s[5 * 33]); o.w = pk2(s[6 * 33], s[7 * 33]);
        *(u32x4*)(WT + (size_t)(row_off + n0 + n) * K + k0 + 8 * c) = o; }
    asm volatile("s_waitcnt lgkmcnt(0)" ::: "memory");
}
struct Args { const float* in[17]; float* out; unsigned char* ws; };

__device__ __forceinline__ void convert_weights(const Args& a, int l, bf16_t* Wb, LAS unsigned char* lds, int gw, int NGW, int wave, int lane) {
    LAS float* scr = (LAS float*)(lds + wave * 16384);
    constexpr int I_IN = 16 * 136, I_AO = 8 * 32, I_CO = 8 * 32, I_OUT = 16 * 32, I_UP = 16 * 128, I_DN = 64 * 32;
    constexpr int NITEMS = I_IN + I_AO + I_CO + I_OUT + I_UP + I_DN;
    const float* w_in = a.in[9] + (size_t)l * DM * IN_DIM; const float* w_ao = a.in[12] + (size_t)l * ATT * DM; const float* w_co = a.in[13] + (size_t)l * CD * DM;
    const float* w_out = a.in[14] + (size_t)l * DM * DM; const float* w_up = a.in[15] + (size_t)l * DM * FF; const float* w_dn = a.in[16] + (size_t)l * FF * DM;
    const float* g_pre = a.in[5] + l * DM; const float* g_mlp = a.in[7] + l * DM;
    for (int it = gw; it < NITEMS; it += NGW) {
        int r = it;
        if (r < I_IN) { transpose_item(w_in, g_pre, DM, IN_DIM, Wb + W_IN, 0, scr, r, lane); continue; } r -= I_IN;
        if (r < I_AO) { transpose_item(w_ao, nullptr, ATT, DM, Wb + W_BR, 0, scr, r, lane); continue; } r -= I_AO;
        if (r < I_CO) { transpose_item(w_co, nullptr, CD, DM, Wb + W_BR, 1024, scr, r, lane); continue; } r -= I_CO;
        if (r < I_OUT) { transpose_item(w_out, nullptr, DM, DM, Wb + W_OUT, 0, scr, r, lane); continue; } r -= I_OUT;
        if (r < I_UP) { transpose_item(w_up, g_mlp, DM, FF, Wb + W_UP, 0, scr, r, lane); continue; } r -= I_UP;
        transpose_item(w_dn, nullptr, FF, DM, Wb + W_DN, 0, scr, r, lane);
    }
}

__device__ __forceinline__ void rows_prologue(const float* xp, const float* xs, bf16_t* xb, float* r, int gw, int NGW, int lane) {
    for (int row0 = gw; row0 < M; row0 += 4 * NGW) {
        f32x4 v[4][4];
#pragma unroll
        for (int b = 0; b < 4; ++b) { const int row = row0 + b * NGW;
            if (row < M) { const float* xr = (row < MP) ? xp + (size_t)row * DM : xs + (size_t)(row - MP) * DM;
#pragma unroll
                for (int j = 0; j < 4; ++j) v[b][j] = *(const f32x4*)(xr + 4 * lane + 256 * j); } }
#pragma unroll
        for (int b = 0; b < 4; ++b) { const int row = row0 + b * NGW;
            if (row < M) { float ss = 0.f;
#pragma unroll
                for (int j = 0; j < 4; ++j) ss += (v[b][j][0] * v[b][j][0] + v[b][j][1] * v[b][j][1]) + (v[b][j][2] * v[b][j][2] + v[b][j][3] * v[b][j][3]);
                ss = wave_sum(ss);
#pragma unroll
                for (int j = 0; j < 4; ++j) { u32x2 w; w.x = pk2(v[b][j][0], v[b][j][1]); w.y = pk2(v[b][j][2], v[b][j][3]); *(u32x2*)(xb + (size_t)row * DM + 4 * lane + 256 * j) = w; }
                if (lane == 0) r[row] = 1.0f / sqrtf(ss * (1.0f / DM) + EPS); } }
    }
}
constexpr int RB = 4;
__device__ __forceinline__ void rows_residual(const bf16_t* src, const float* part, const float* xin_p, const float* xin_s, const float* g, float* xout, bf16_t* xb, float* r, int gw, int NGW, int lane) {
    f32x4 gv[4];
#pragma unroll
    for (int j = 0; j < 4; ++j) gv[j] = *(const f32x4*)(g + 4 * lane + 256 * j);
    for (int row0 = gw; row0 < M; row0 += RB * NGW) {
        f32x4 s[RB][4], x[RB][4];
#pragma unroll
        for (int b = 0; b < RB; ++b) {
            const int row = row0 + b * NGW;
            if (row < M) {
                const float* xr = (row < MP) ? xin_p + (size_t)row * DM : xin_s + (size_t)(row - MP) * DM;
#pragma unroll
                for (int j = 0; j < 4; ++j) { x[b][j] = *(const f32x4*)(xr + 4 * lane + 256 * j);
                    if (row < MP) { const u32x2 w = *(const u32x2*)(src + (size_t)row * DM + 4 * lane + 256 * j);
                        s[b][j][0] = bf2f(w.x & 0xffffu); s[b][j][1] = __uint_as_float(w.x & 0xffff0000u); s[b][j][2] = bf2f(w.y & 0xffffu); s[b][j][3] = __uint_as_float(w.y & 0xffff0000u); }
                    else { const float* pp = part + (size_t)(row - MP) * DM + 4 * lane + 256 * j; s[b][j] = *(const f32x4*)pp;
#pragma unroll
                        for (int q = 1; q < NSL; ++q) s[b][j] += *(const f32x4*)(pp + (size_t)q * MS * DM); } }
            }
        }
#pragma unroll
        for (int b = 0; b < RB; ++b) {
            const int row = row0 + b * NGW;
            if (row < M) {
                float ss = 0.f;
#pragma unroll
                for (int j = 0; j < 4; ++j) ss += (s[b][j][0] * s[b][j][0] + s[b][j][1] * s[b][j][1]) + (s[b][j][2] * s[b][j][2] + s[b][j][3] * s[b][j][3]);
                ss = wave_sum(ss);
                const float rm = 1.0f / sqrtf(ss * (1.0f / DM) + EPS);
                float s2 = 0.f;
#pragma unroll
                for (int j = 0; j < 4; ++j) { x[b][j] = x[b][j] + s[b][j] * rm * gv[j]; s2 += (x[b][j][0] * x[b][j][0] + x[b][j][1] * x[b][j][1]) + (x[b][j][2] * x[b][j][2] + x[b][j][3] * x[b][j][3]); }
                s2 = wave_sum(s2);
#pragma unroll
                for (int j = 0; j < 4; ++j) { *(f32x4*)(xout + (size_t)row * DM + 4 * lane + 256 * j) = x[b][j];
                    u32x2 w; w.x = pk2(x[b][j][0], x[b][j][1]); w.y = pk2(x[b][j][2], x[b][j][3]); *(u32x2*)(xb + (size_t)row * DM + 4 * lane + 256 * j) = w; }
                if (lane == 0) r[row] = 1.0f / sqrtf(s2 * (1.0f / DM) + EPS);
            }
        }
    }
}

constexpr int KS_STRIDE = 72, VT_STRIDE = 264;
constexpr int VT_OFF = 256 * KS_STRIDE * 2;
constexpr float SC_L2 = 0.125f * LOG2E;

template <bool SAMPLE>
__device__ __forceinline__ void attn_qtile(const LAS unsigned char* lds, const bf16_t* Z, bf16_t* AO, int qrow, int head, int iq, int tb, bool has_prev, float sink_l2, int lane) {
    const int q = lane & 15, g = lane >> 4;
    const bf16x8 qf0 = *(const bf16x8*)(Z + (size_t)qrow * ZP + ZQ + head * 64 + 8 * g);
    const bf16x8 qf1 = *(const bf16x8*)(Z + (size_t)qrow * ZP + ZQ + head * 64 + 32 + 8 * g);
    f32x4 s[10];
    const LAS unsigned char* kbase = lds + ((tb * 16 + q) * KS_STRIDE + 8 * g) * 2;
    const int lo1 = (!SAMPLE && !has_prev && iq < 127) ? 128 : iq + 1;
    const unsigned span = (unsigned)(iq + 128 - lo1);
    const int d0 = tb * 16 + 4 * g - lo1;
    float mx = sink_l2;
#pragma unroll
    for (int t = 0; t < 10; ++t) {
        const bf16x8 a0 = *(const LAS bf16x8*)(kbase + t * 16 * KS_STRIDE * 2);
        const bf16x8 a1 = *(const LAS bf16x8*)(kbase + t * 16 * KS_STRIDE * 2 + 64);
        f32x4 z = {0.f, 0.f, 0.f, 0.f};
        z = __builtin_amdgcn_mfma_f32_16x16x32_bf16(a0, qf0, z, 0, 0, 0);
        z = __builtin_amdgcn_mfma_f32_16x16x32_bf16(a1, qf1, z, 0, 0, 0);
#pragma unroll
        for (int j = 0; j < 4; ++j) {
            const bool vis = (unsigned)(d0 + t * 16 + j) <= span;
            const float v = vis ? z[j] * SC_L2 : -INFINITY;
            z[j] = v; mx = fmaxf(mx, v);
        }
        s[t] = z;
    }
    mx = fmaxf(mx, __shfl_xor(mx, 16)); mx = fmaxf(mx, __shfl_xor(mx, 32));
    float sum = 0.f;
#pragma unroll
    for (int t = 0; t < 10; ++t)
#pragma unroll
        for (int j = 0; j < 4; ++j) { const float p = __builtin_amdgcn_exp2f(s[t][j] - mx); s[t][j] = p; sum += p; }
    sum += __shfl_xor(sum, 16); sum += __shfl_xor(sum, 32);
    sum += __builtin_amdgcn_exp2f(sink_l2 - mx);
    const float inv = 1.0f / sum;
    bf16x8 pf[5];
#pragma unroll
    for (int c = 0; c < 5; ++c) {
        u32x4 w; w.x = pk2(s[2 * c][0] * inv, s[2 * c][1] * inv); w.y = pk2(s[2 * c][2] * inv, s[2 * c][3] * inv);
        w.z = pk2(s[2 * c + 1][0] * inv, s[2 * c + 1][1] * inv); w.w = pk2(s[2 * c + 1][2] * inv, s[2 * c + 1][3] * inv);
        pf[c] = __builtin_bit_cast(bf16x8, w);
    }
    f32x4 o[4];
#pragma unroll
    for (int dt = 0; dt < 4; ++dt) o[dt] = (f32x4){0.f, 0.f, 0.f, 0.f};
    const LAS unsigned char* vbase = lds + VT_OFF + (q * VT_STRIDE + tb * 16 + 4 * g) * 2;
#pragma unroll
    for (int c = 0; c < 5; ++c)
#pragma unroll
        for (int dt = 0; dt < 4; ++dt) {
            const u32x2 lo = *(const LAS u32x2*)(vbase + dt * 16 * VT_STRIDE * 2 + c * 64);
            const u32x2 hi = *(const LAS u32x2*)(vbase + dt * 16 * VT_STRIDE * 2 + c * 64 + 32);
            const u32x4 av = {lo.x, lo.y, hi.x, hi.y};
            o[dt] = __builtin_amdgcn_mfma_f32_16x16x32_bf16(__builtin_bit_cast(bf16x8, av), pf[c], o[dt], 0, 0, 0);
        }
#pragma unroll
    for (int dt = 0; dt < 4; ++dt) { u32x2 w; w.x = pk2(o[dt][0], o[dt][1]); w.y = pk2(o[dt][2], o[dt][3]);
        *(u32x2*)(AO + (size_t)qrow * ATT + head * 64 + dt * 16 + 4 * g) = w; }
}

__device__ __forceinline__ void lds_put_kv(LAS unsigned char* lds, int key, int ch, u32x4 kv, u32x4 vv) {
    *(LAS u32x4*)(lds + key * (KS_STRIDE * 2) + ch * 16) = kv;
    LAS unsigned short* vt = (LAS unsigned short*)(lds + VT_OFF) + (ch * 8) * VT_STRIDE + key;
    vt[0 * VT_STRIDE] = (unsigned short)(vv.x & 0xffffu); vt[1 * VT_STRIDE] = (unsigned short)(vv.x >> 16);
    vt[2 * VT_STRIDE] = (unsigned short)(vv.y & 0xffffu); vt[3 * VT_STRIDE] = (unsigned short)(vv.y >> 16);
    vt[4 * VT_STRIDE] = (unsigned short)(vv.z & 0xffffu); vt[5 * VT_STRIDE] = (unsigned short)(vv.z >> 16);
    vt[6 * VT_STRIDE] = (unsigned short)(vv.w & 0xffffu); vt[7 * VT_STRIDE] = (unsigned short)(vv.w >> 16);
}
__device__ __forceinline__ void store8f(float* dst, const u32x4 v) { float f[8]; unpack8(v, f); *(f32x4*)dst = (f32x4){f[0], f[1], f[2], f[3]}; *(f32x4*)(dst + 4) = (f32x4){f[4], f[5], f[6], f[7]}; }

__device__ __forceinline__ void attn_prompt_unit(const Args& a, int l, int unit, const bf16_t* Z, bf16_t* AO, LAS unsigned char* lds, int tid, int wave, int lane) {
    const int b = unit >> 5, qb = (unit >> 1) & 15, kvh = unit & 1;
    const int rowbase = b * SEQ + qb * 128;
    const bool has_prev = qb > 0;
#pragma unroll
    for (int i = 0; i < 4; ++i) {
        const int item = tid + NTHREADS * i, key = item >> 3, ch = item & 7;
        u32x4 kv = {0u, 0u, 0u, 0u}, vv = {0u, 0u, 0u, 0u};
        if (has_prev || key >= 128) {
            const bf16_t* zr = Z + (size_t)(rowbase - 128 + key) * ZP + kvh * 64 + ch * 8;
            kv = *(const u32x4*)(zr + ZK); vv = *(const u32x4*)(zr + ZV);
            if (qb == 15 && key >= 128) {
                const size_t o = (((size_t)(l * NBATCH + b) * 128 + (key - 128)) * 2 + kvh) * 64 + ch * 8;
                store8f(a.out + O_KP + o, kv); store8f(a.out + O_VP + o, vv);
            }
        }
        lds_put_kv(lds, key, ch, kv, vv);
    }
    __syncthreads();
    const int hh = wave >> 1, half = wave & 1, head = kvh * 4 + hh;
    const float sink_l2 = a.in[10][l * 8 + head] * LOG2E;
#pragma unroll 1
    for (int qt = 0; qt < 4; ++qt) {
        const int iq0 = half * 64 + qt * 16, iq = iq0 + (lane & 15);
        attn_qtile<false>(lds, Z, AO, rowbase + iq, head, iq, (iq0 >> 4) & ~1, has_prev, sink_l2, lane);
    }
    __syncthreads();
}
__device__ __forceinline__ void attn_sample_unit(const Args& a, int l, int unit, const bf16_t* Z, bf16_t* AO, LAS unsigned char* lds, int tid, int wave, int lane) {
    const int n = unit >> 1, kvh = unit & 1;
    const float* ck = a.in[2] + ((size_t)(l * DBATCH + n) * 128) * 128 + kvh * 64;
    const float* cv = a.in[3] + ((size_t)(l * DBATCH + n) * 128) * 128 + kvh * 64;
#pragma unroll
    for (int i = 0; i < 3; ++i) {
        const int item = tid + NTHREADS * i, key = item >> 3, ch = item & 7;
        if (item < 160 * 8) {
            u32x4 kv = {0u, 0u, 0u, 0u}, vv = {0u, 0u, 0u, 0u};
            const size_t o = (((size_t)(l * DBATCH + n) * 128 + (key - 8)) * 2 + kvh) * 64 + ch * 8;
            if (key < 128) {
                const f32x4 k0 = *(const f32x4*)(ck + (size_t)key * 128 + ch * 8), k1 = *(const f32x4*)(ck + (size_t)key * 128 + ch * 8 + 4);
                const f32x4 v0 = *(const f32x4*)(cv + (size_t)key * 128 + ch * 8), v1 = *(const f32x4*)(cv + (size_t)key * 128 + ch * 8 + 4);
                kv = (u32x4){pk2(k0[0], k0[1]), pk2(k0[2], k0[3]), pk2(k1[0], k1[1]), pk2(k1[2], k1[3])};
                vv = (u32x4){pk2(v0[0], v0[1]), pk2(v0[2], v0[3]), pk2(v1[0], v1[1]), pk2(v1[2], v1[3])};
                if (key >= 8) { *(f32x4*)(a.out + O_KS + o) = k0; *(f32x4*)(a.out + O_KS + o + 4) = k1; *(f32x4*)(a.out + O_VS + o) = v0; *(f32x4*)(a.out + O_VS + o + 4) = v1; }
            } else if (key < 136) {
                const bf16_t* zr = Z + (size_t)(MP + n * DSEQ + (key - 128)) * ZP + kvh * 64 + ch * 8;
                kv = *(const u32x4*)(zr + ZK); vv = *(const u32x4*)(zr + ZV);
                store8f(a.out + O_KS + o, kv); store8f(a.out + O_VS + o, vv);
            }
            lds_put_kv(lds, key, ch, kv, vv);
        }
    }
    __syncthreads();
    if (wave < 2) {
        const int q = lane & 15, head = kvh * 4 + wave * 2 + (q >> 3), t = q & 7;
        const float sink_l2 = a.in[10][l * 8 + head] * LOG2E;
        attn_qtile<true>(lds, Z, AO, MP + n * DSEQ + t, head, t, 0, true, sink_l2, lane);
    }
    __syncthreads();
}

__device__ __forceinline__ void conv_phase(const Args& a, int l, const bf16_t* Z, bf16_t* BZ, int gtid, int nth) {
    const float* cw = a.in[11] + (size_t)l * 3 * CD;
    for (int item = gtid; item < (M / 4) * 64; item += nth) {
        const int row0 = (item >> 6) * 4, c0 = (item & 63) * 8;
        const bool smp = row0 >= MP;
        const int t0 = smp ? ((row0 - MP) & 7) : (row0 & (SEQ - 1));
        const int n = smp ? ((row0 - MP) >> 3) : (row0 >> 11);
        const bf16_t* zr = Z + (size_t)row0 * ZP + c0;
        u32x4 rB[4], rC[6], rU[6];
#pragma unroll
        for (int i = 0; i < 4; ++i) { rB[i] = *(const u32x4*)(zr + (size_t)i * ZP + ZB); rC[i + 2] = *(const u32x4*)(zr + (size_t)i * ZP + ZC); rU[i + 2] = *(const u32x4*)(zr + (size_t)i * ZP + ZU); }
        float up[6][8];
        if (t0 > 0) {
#pragma unroll
            for (int i = 0; i < 2; ++i) { rC[i] = *(const u32x4*)(zr - (size_t)(2 - i) * ZP + ZC); rU[i] = *(const u32x4*)(zr - (size_t)(2 - i) * ZP + ZU); }
#pragma unroll
            for (int i = 0; i < 2; ++i) { float cv[8], uv[8]; unpack8(rC[i], cv); unpack8(rU[i], uv);
#pragma unroll
                for (int e = 0; e < 8; ++e) up[i][e] = cv[e] * uv[e]; }
        } else if (smp) {
#pragma unroll
            for (int i = 0; i < 2; ++i) { const float* sp = a.in[4] + ((size_t)(l * DBATCH + n) * 2 + i) * CD + c0;
#pragma unroll
                for (int e = 0; e < 8; ++e) up[i][e] = sp[e]; }
        } else {
#pragma unroll
            for (int i = 0; i < 2; ++i)
#pragma unroll
                for (int e = 0; e < 8; ++e) up[i][e] = 0.f;
        }
#pragma unroll
        for (int i = 2; i < 6; ++i) { float cv[8], uv[8]; unpack8(rC[i], cv); unpack8(rU[i], uv);
#pragma unroll
            for (int e = 0; e < 8; ++e) up[i][e] = cv[e] * uv[e]; }
        float w0[8], w1[8], w2[8];
#pragma unroll
        for (int e = 0; e < 8; ++e) { w0[e] = cw[c0 + e]; w1[e] = cw[CD + c0 + e]; w2[e] = cw[2 * CD + c0 + e]; }
        const int tl = smp ? DSEQ : SEQ;
#pragma unroll
        for (int i = 0; i < 4; ++i) {
            float bv[8], o[8]; unpack8(rB[i], bv);
#pragma unroll
            for (int e = 0; e < 8; ++e) o[e] = bv[e] * (w0[e] * up[i][e] + w1[e] * up[i + 1][e] + w2[e] * up[i + 2][e]);
            *(u32x4*)(BZ + (size_t)(row0 + i) * CD + c0) = pack8(o);
            if (i >= 2 && t0 + 4 == tl) {
                float* dst = smp ? a.out + O_CS + ((size_t)(l * DBATCH + n) * 2 + (i - 2)) * CD + c0 : a.out + O_CP + ((size_t)(l * NBATCH + n) * 2 + (i - 2)) * CD + c0;
                *(f32x4*)dst = (f32x4){up[i + 2][0], up[i + 2][1], up[i + 2][2], up[i + 2][3]}; *(f32x4*)(dst + 4) = (f32x4){up[i + 2][4], up[i + 2][5], up[i + 2][6], up[i + 2][7]};
            }
        }
    }
}

#define RLX_AGENT __ATOMIC_RELAXED, __HIP_MEMORY_SCOPE_AGENT
#define XB_TMO      128
#define XB_XCNT(j)  (256  + 64 * (j))
#define XB_XSUB(j)  (1280 + 64 * (j))
#define XB_XGEN(j)  (2304 + 64 * (j))
#define XB_TOP      3328
#define XB_TOPGEN   3392
#define XCD_BAR_WORDS 3456
#define XB_SPIN_CAP (1u << 18)

__device__ __forceinline__ unsigned xb_ld(unsigned* p)              { return __hip_atomic_load(p, __ATOMIC_RELAXED, __HIP_MEMORY_SCOPE_AGENT); }
__device__ __forceinline__ unsigned xb_add(unsigned* p, unsigned v) { return __hip_atomic_fetch_add(p, v, __ATOMIC_RELAXED, __HIP_MEMORY_SCOPE_AGENT); }
__device__ __forceinline__ unsigned xb_xcc_id() { return (unsigned)__builtin_amdgcn_s_getreg((3 << 11) | 20) & 0xFu; }
#define XB_SPIN(cond, bar) do { unsigned _sp = 0; while (cond) { __builtin_amdgcn_s_sleep(1); \
    if ((++_sp & 255u) == 0u) { if (xb_ld(&(bar)[XB_TMO])) break; if (_sp > XB_SPIN_CAP) { atomicAdd(&(bar)[XB_TMO], 1u); break; } } } } while (0)

struct XcdBarrier {
    unsigned* bar; unsigned x;
    volatile LAS unsigned* st;
};

__device__ __forceinline__ XcdBarrier xcd_barrier_post(unsigned* bar, volatile LAS unsigned* st) {
    XcdBarrier b; b.bar = bar; b.x = xb_xcc_id(); b.st = st;
    if (threadIdx.x == 0) (void)xb_add(&bar[XB_XCNT(b.x)], 1u);
    return b;
}
__device__ __forceinline__ void xcd_barrier_complete(unsigned* bar, unsigned x, unsigned& nloc, unsigned& nx) {
    const unsigned G = gridDim.x * gridDim.y * gridDim.z;
    unsigned sum, cnt, mine, sp = 0u;
    for (;;) {
        sum = 0u; cnt = 0u; mine = 0u;
#pragma unroll
        for (unsigned j = 0; j < 16; ++j) { const unsigned c = xb_ld(&bar[XB_XCNT(j)]); sum += c; cnt += (c > 0u) ? 1u : 0u; mine = (j == x) ? c : mine; }
        if (sum == G) break;
        __builtin_amdgcn_s_sleep(1);
        if ((++sp & 255u) == 0u) { if (xb_ld(&bar[XB_TMO])) break; if (sp > XB_SPIN_CAP) { atomicAdd(&bar[XB_TMO], 1u); break; } }
    }
    nloc = mine > 0u ? mine : 1u; nx = cnt > 0u ? cnt : 1u;
}

__device__ __forceinline__ void xcd_barrier(const XcdBarrier& b) {
    asm volatile("s_waitcnt vmcnt(0)" ::: "memory");
    __syncthreads();
    if (threadIdx.x == 0) {
        unsigned* bar = b.bar;
        __builtin_amdgcn_s_waitcnt(0);
        unsigned nloc = b.st[0], nx = b.st[1];
        if (nloc == 0u) { xcd_barrier_complete(bar, b.x, nloc, nx); b.st[0] = nloc; b.st[1] = nx; }
        const unsigned old = xb_add(&bar[XB_XSUB(b.x)], 1u);
        const unsigned gen = old / nloc;
        if (old + 1u == (gen + 1u) * nloc) {
            __builtin_amdgcn_fence(__ATOMIC_RELEASE, "agent");
            asm volatile("s_waitcnt vmcnt(0)" ::: "memory");
            const unsigned og = xb_add(&bar[XB_TOP], 1u);
            const unsigned tg = og / nx;
            if (og + 1u == (tg + 1u) * nx) xb_add(&bar[XB_TOPGEN], 1u);
            else XB_SPIN(xb_ld(&bar[XB_TOPGEN]) == tg, bar);
            __builtin_amdgcn_fence(__ATOMIC_ACQUIRE, "agent");
            xb_add(&bar[XB_XGEN(b.x)], 1u);
            asm volatile("s_waitcnt vmcnt(0)" ::: "memory");
        } else {
            XB_SPIN(xb_ld(&bar[XB_XGEN(b.x)]) == gen, bar);
            __builtin_amdgcn_fence(__ATOMIC_ACQUIRE, "agent");
            asm volatile("s_waitcnt vmcnt(0)" ::: "memory");
        }
    }
    __syncthreads();
}
__device__ __forceinline__ Args fresh_args() {
#if defined(__HIP_DEVICE_COMPILE__)
    const CAS unsigned long long* p = (const CAS unsigned long long*)__builtin_amdgcn_kernarg_segment_ptr(); asm volatile("" : "+s"(p));
    Args a;
#pragma unroll
    for (int i = 0; i < 17; ++i) a.in[i] = (const float*)p[i];
    a.out = (float*)p[17]; a.ws = (unsigned char*)p[18];
    return a;
#else
    return Args{};
#endif
}
__global__ void __launch_bounds__(NTHREADS, 2) fwd_megakernel(Args a_unused) {
    extern __shared__ __attribute__((aligned(16))) unsigned char lds_raw[];
    LAS unsigned char* lds = (LAS unsigned char*)lds_raw;
    cg::grid_group grid = cg::this_grid();
    const int G = gridDim.x, bx = blockIdx.x, NGW = G * NWAVES;
#define FRESH() int tid = threadIdx.x; asm volatile("" : "+v"(tid)); const int lane = tid & 63, wave = __builtin_amdgcn_readfirstlane(tid >> 6), gw = bx * NWAVES + wave; (void)lane; (void)gw
#define PTRS() const Args a = fresh_args(); unsigned char* ws = a.ws; \
    float* R = (float*)(ws + WS_R); bf16_t* Wb = (bf16_t*)(ws + WS_W); bf16_t* Z = (bf16_t*)(ws + WS_Z); bf16_t* S1 = (bf16_t*)(ws + WS_S1); bf16_t* S2 = (bf16_t*)(ws + WS_S2); float* Y = a.out + O_Y; \
    (void)R; (void)Wb; (void)Z; (void)S1; (void)S2; (void)Y

    volatile LAS unsigned* bst = (volatile LAS unsigned*)(lds + 131072 + 64);
    { FRESH(); PTRS(); unsigned* barw = (unsigned*)(ws + WS_BAR);
      if (tid < 2) bst[tid] = 0u;
      if (bx == 0) for (int i = tid; i < XCD_BAR_WORDS; i += NTHREADS) __hip_atomic_store(barw + i, 0u, RLX_AGENT);
      for (int rep_ = 0; rep_ < 1 + ((REPMASK >> 6) & 1); ++rep_) convert_weights(a, 0, Wb, lds, gw, NGW, wave, lane);
      for (int rep_ = 0; rep_ < 1 + ((REPMASK >> 7) & 1); ++rep_) rows_prologue(a.in[0], a.in[1], S2, R, gw, NGW, lane); }
    grid.sync();
    XcdBarrier xbar;
    { PTRS(); xbar = xcd_barrier_post((unsigned*)(ws + WS_BAR), bst); }
#define GSYNC() do { XcdBarrier xb_ = xbar; asm volatile("" : "+s"(xb_.bar), "+s"(xb_.x)); xcd_barrier(xb_); } while (0)

#pragma unroll 1
    for (int l = 0; l < DEPTH; ++l) {
        for (int rep_ = 0; rep_ < 1 + ((REPMASK >> 0) & 1); ++rep_) {
            PTRS();
            pg8::Gemm g{l == 0 ? S2 : S1, Wb + W_IN, M, IN_DIM, DM}; pg8::StaticOrder S; S.init(M, IN_DIM, G, bx);
            Epi<1> E{Z, ZP, R, Z, nullptr};
            pg8::gemm_phase<Epi<1>, pg8::StaticOrder, true, true>(lds, g, S, E);
            GSYNC();
        }
        for (int rep_ = 0; rep_ < 1 + ((REPMASK >> 1) & 1); ++rep_) {
            FRESH(); PTRS();
            for (int u = bx; u < NBATCH * 16 * 2; u += G) attn_prompt_unit(a, l, u, Z, S1, lds, tid, wave, lane);
            for (int u = bx; u < DBATCH * 2; u += G) attn_sample_unit(a, l, u, Z, S1, lds, tid, wave, lane);
            conv_phase(a, l, Z, S1 + (size_t)M * ATT, bx * NTHREADS + tid, G * NTHREADS);
            GSYNC();
        }
        for (int rep_ = 0; rep_ < 1 + ((REPMASK >> 2) & 1); ++rep_) {
            PTRS();
            pg8::Gemm g{S1, Wb + W_BR, 2 * M, 2048, 512}; PairOrder S; S.init(G, bx);
            Epi<3> E{S2, DM, R, Z, nullptr};
            pg8::gemm_phase<Epi<3>, PairOrder, true, true>(lds, g, S, E);
            GSYNC();
        }
        for (int rep_ = 0; rep_ < 1 + ((REPMASK >> 3) & 1); ++rep_) {
            PTRS();
            pg8::Gemm g{S2, Wb + W_OUT, M, DM, DM}; SliceOrder S; S.init(G, bx, 32 / NSL, 16);
            Epi<4> E{S1, DM, R, Z, (float*)Z};
            pg8::gemm_phase<Epi<4>, SliceOrder, true, true>(lds, g, S, E);
            GSYNC();
        }
        { FRESH(); PTRS(); rows_residual(S1, (const float*)Z, l == 0 ? a.in[0] : Y, l == 0 ? a.in[1] : Y + (size_t)MP * DM, a.in[6] + l * DM, Y, S2, R, gw, NGW, lane); }
        GSYNC();
        for (int rep_ = 0; rep_ < 1 + ((REPMASK >> 4) & 1); ++rep_) {
            PTRS();
            pg8::Gemm g{S2, Wb + W_UP, M, FF, DM}; pg8::StaticOrder S; S.init(M, FF, G, bx);
            Epi<6> E{Z, FF, R, Z, nullptr};
            pg8::gemm_phase<Epi<6>, pg8::StaticOrder, true, true>(lds, g, S, E);
            GSYNC();
        }
        for (int rep_ = 0; rep_ < 1 + ((REPMASK >> 5) & 1); ++rep_) {
            PTRS();
            pg8::Gemm g{Z, Wb + W_DN, M, DM, FF}; SliceOrder S; S.init(G, bx, 64 / NSL, 64);
            Epi<4> E{S1, DM, R, Z, (float*)S2};
            pg8::gemm_phase<Epi<4>, SliceOrder, true, true>(lds, g, S, E);
            GSYNC();
        }
        { FRESH(); PTRS(); rows_residual(S1, (const float*)S2, Y, Y + (size_t)MP * DM, a.in[8] + l * DM, Y, S1, R, gw, NGW, lane);
          if (l + 1 < DEPTH) for (int rep_ = 0; rep_ < 1 + ((REPMASK >> 6) & 1); ++rep_) convert_weights(a, l + 1, Wb, lds, gw, NGW, wave, lane); }
        if (l + 1 < DEPTH) GSYNC();
    }
}

extern "C" void kernel_launch(void* const* d_in, const int* in_sizes, int n_in, void* d_out, int out_size, void* d_ws, size_t ws_size, hipStream_t stream) {
    static int grid = 0;
    if (grid == 0) {
        if (n_in != 17 || ws_size < WS_END) { fprintf(stderr, "kernel_launch: unexpected n_in %d / ws_size %zu (need %zu)\n", n_in, ws_size, (size_t)WS_END); grid = -1; return; }
        int dev = 0, cus = 0, per_cu = 0;
        hipGetDevice(&dev);
        hipDeviceGetAttribute(&cus, hipDeviceAttributeMultiprocessorCount, dev);
        if (hipFuncSetAttribute((const void*)fwd_megakernel, hipFuncAttributeMaxDynamicSharedMemorySize, LDS_BYTES) != hipSuccess) fprintf(stderr, "kernel_launch: hipFuncSetAttribute failed\n");
        if (hipOccupancyMaxActiveBlocksPerMultiprocessor(&per_cu, (const void*)fwd_megakernel, NTHREADS, LDS_BYTES) != hipSuccess || per_cu < 1) { fprintf(stderr, "kernel_launch: occupancy query gave %d\n", per_cu); per_cu = 1; }
        (void)hipGetLastError();
        grid = cus * per_cu;
    }
    if (grid < 0) return;
    Args a{};
    for (int i = 0; i < 17; ++i) a.in[i] = (const float*)d_in[i];
    a.out = (float*)d_out; a.ws = (unsigned char*)d_ws;
    void* args[] = {&a};
    hipError_t e = hipLaunchCooperativeKernel((const void*)fwd_megakernel, dim3(grid), dim3(NTHREADS), args, LDS_BYTES, stream);
    if (e != hipSuccess) fprintf(stderr, "cooperative launch failed: %s (grid %d)\n", hipGetErrorString(e), grid);
}
```

```cpp
#include <hip/hip_runtime.h>
#include <hip/hip_cooperative_groups.h>
#include <cstdio>
#include <cstdint>
namespace cg = cooperative_groups;
namespace pg8 {
#define PG8_LAS __attribute__((address_space(3)))
typedef unsigned short bf16_t;
typedef short bf16x8 __attribute__((ext_vector_type(8)));
typedef float f32x4 __attribute__((ext_vector_type(4)));
typedef unsigned u32x4 __attribute__((ext_vector_type(4)));
constexpr int BM = 256, BK = 64, HALF = 128, HTB = HALF * BK * 2  , STAGE_BYTES = 8 * HTB, NXCD = 8, WGM = 8;

__host__ __device__ __forceinline__ int lds_byte(int r, int c) { const int st = (r >> 4) * 2 + (c >> 5), rr = r & 15, cc = c & 31, ob = rr * 64 + cc * 2; return st * 1024 + (ob ^ (((ob >> 9) & 1) << 5)); }
__host__ __device__ __forceinline__ void stage_rc(int b, int& R, int& C) { const int st = b / 1024, sb = b % 1024, swz = sb ^ (((sb >> 9) & 1) << 5); R = (st >> 1) * 16 + swz / 64; C = (st & 1) * 32 + (swz % 64) / 2; }
__host__ __device__ __forceinline__ int perm32(int rho) { const int n = rho >> 4, i = rho & 15; return 8 * (i >> 2) + 4 * n + (i & 3); }

struct Unit { int pm, pn, pa, pb, w, koff, nt; };
struct Gemm { const bf16_t* A; const bf16_t* Bt; int M, N, K; };

struct StaticOrder {
    int nM, nN, nwg, G, c;
    __host__ __device__ __forceinline__ void init(int M, int N, int G_, int c_) { nM = M / BM; nN = N / BM; nwg = nM * nN; G = G_; c = c_; }
    __host__ __device__ __forceinline__ bool next(int i, Unit& u) const {
        const long L = (long)i * G + c; if (L >= nwg) return false;
        int wgid = (int)L; { const int q = nwg / NXCD, r = nwg % NXCD, xcd = wgid % NXCD, off = wgid / NXCD; wgid = (xcd < r ? xcd * (q + 1) : r * (q + 1) + (xcd - r) * q) + off; }
        const int nig = WGM * nN, gid = wgid / nig, fm = gid * WGM, gsz = (nM - fm) < WGM ? (nM - fm) : WGM;
        u.pm = fm + ((wgid % nig) % gsz); u.pn = (wgid % nig) / gsz; u.pa = u.pm; u.pb = u.pn; u.w = 0; u.koff = 0; u.nt = 0; return true;
    }
    __device__ __forceinline__ void a_ready(const Unit&) const {}
    __device__ __forceinline__ void done(const Unit&) const {}
};
__device__ __forceinline__ unsigned cvt_pk_bf16(float lo, float hi) { unsigned r; asm volatile("v_cvt_pk_bf16_f32 %0, %1, %2" : "=v"(r) : "v"(lo), "v"(hi)); return r; }
template <class Epi, class Sched, bool ALIGN_EPI = false, bool SP2 = false>
__device__ __forceinline__ void gemm_phase(PG8_LAS unsigned char* lds, const Gemm g, const Sched& S, const Epi& E) {
    int tid_ = threadIdx.x; asm volatile("" : "+v"(tid_));
    const int tid = tid_, wid = __builtin_amdgcn_readfirstlane(tid >> 6), lane = tid & 63, wr = wid >> 2, wc = wid & 3, fr = lane & 15, fq = lane >> 4;
    const int K = g.K, nt = K / BK;
    unsigned voffA[2], voffB[2];
#pragma unroll
    for (int i = 0; i < 2; ++i) { int R, C; stage_rc(tid * 16 + i * 8192, R, C); const int Rb = Epi::PERM ? ((R & ~31) + perm32(R & 31)) : R;
        voffA[i] = (unsigned)(R * K + C) * 2u; voffB[i] = (unsigned)(Rb * K + C) * 2u; }
    const size_t kstep = (size_t)(BK * 2);
    const size_t hstep = (size_t)HALF * K * 2;
    const size_t tstep = 2 * hstep;
    const unsigned ldsw = (unsigned)wid * 1024u;
    const int aoff = lds_byte(wr * 64 + fr, fq * 8), boff = lds_byte(wc * 32 + fr, fq * 8);
#define PG8_SA(b, h) (((b) * 2 + (h)) * HTB)
#define PG8_SB(b, h) ((4 + (b) * 2 + (h)) * HTB)
#define PG8_STAGE(bufoff, gbase, voff) do { _Pragma("unroll") for (int _i = 0; _i < 2; ++_i) \
        __builtin_amdgcn_global_load_lds((const unsigned*)((const char*)(gbase) + (voff)[_i]), (PG8_LAS unsigned*)(lds + (bufoff) + ldsw + _i * 8192), 16, 0, 0); } while (0)
#define PG8_LDA(dst, b, h) do { _Pragma("unroll") for (int m = 0; m < 4; ++m) _Pragma("unroll") for (int k = 0; k < 2; ++k) dst[m][k] = *(const PG8_LAS bf16x8*)(lds + PG8_SA(b, h) + aoff + m * 2048 + k * 1024); } while (0)
#define PG8_LDB(dst, b, h) do { _Pragma("unroll") for (int n = 0; n < 2; ++n) _Pragma("unroll") for (int k = 0; k < 2; ++k) dst[n][k] = *(const PG8_LAS bf16x8*)(lds + PG8_SB(b, h) + boff + n * 2048 + k * 1024); } while (0)
#define PG8_MMA(ai, bj, At, Bt) do { __builtin_amdgcn_s_setprio(1); _Pragma("unroll") for (int m = 0; m < 4; ++m) _Pragma("unroll") for (int n = 0; n < 2; ++n) _Pragma("unroll") for (int k = 0; k < 2; ++k) \
        acc[ai][bj][m][n] = __builtin_amdgcn_mfma_f32_16x16x32_bf16(Bt[n][k], At[m][k], acc[ai][bj][m][n], 0, 0, 0); __builtin_amdgcn_s_setprio(0); } while (0)
#define PG8_WAIT_V(n) asm volatile("s_waitcnt vmcnt(" #n ")" ::: "memory")
#define PG8_WAIT_L(n) asm volatile("s_waitcnt lgkmcnt(" #n ")" ::: "memory")
#define PG8_BAR __builtin_amdgcn_s_barrier()
#define PG8_SCHED __builtin_amdgcn_sched_barrier(0)
    Unit cur, nxt; int ui = 0;
    if (!S.next(0, cur)) return;
    f32x4 acc[2][2][4][2];
#pragma unroll
    for (int a = 0; a < 2; ++a)
#pragma unroll
        for (int b = 0; b < 2; ++b)
#pragma unroll
            for (int m = 0; m < 4; ++m)
#pragma unroll
                for (int n = 0; n < 2; ++n) acc[a][b][m][n] = (f32x4){0.f, 0.f, 0.f, 0.f};
    bf16x8 At[4][2], B0[2][2], B1[2][2];
    const char* cA = (const char*)g.A + (size_t)cur.pa * tstep + cur.koff; const char* cB = (const char*)g.Bt + (size_t)cur.pb * tstep + cur.koff;
    S.a_ready(cur);
    if constexpr (SP2) {
        PG8_STAGE(PG8_SB(0, 0), cB, voffB); PG8_STAGE(PG8_SB(0, 1), cB + hstep, voffB); PG8_STAGE(PG8_SA(0, 0), cA, voffA); PG8_STAGE(PG8_SA(0, 1), cA + hstep, voffA);
        if (wr == 1) PG8_BAR;
        PG8_WAIT_V(2); PG8_BAR;
        PG8_STAGE(PG8_SB(1, 0), cB + kstep, voffB); PG8_STAGE(PG8_SA(1, 0), cA + kstep, voffA); PG8_STAGE(PG8_SB(1, 1), cB + hstep + kstep, voffB);
        PG8_WAIT_V(6); PG8_BAR;
    } else {
        PG8_STAGE(PG8_SB(0, 0), cB, voffB); PG8_STAGE(PG8_SA(0, 0), cA, voffA); PG8_STAGE(PG8_SB(0, 1), cB + hstep, voffB); PG8_STAGE(PG8_SA(0, 1), cA + hstep, voffA);
        if (wr == 1) PG8_BAR;
        PG8_WAIT_V(4); PG8_BAR;
        PG8_STAGE(PG8_SB(1, 0), cB + kstep, voffB); PG8_STAGE(PG8_SA(1, 0), cA + kstep, voffA); PG8_STAGE(PG8_SB(1, 1), cB + hstep + kstep, voffB);
        PG8_WAIT_V(6); PG8_BAR;
    }
    for (;;) {
        const bool has_next = S.next(ui + 1, nxt);
        const char* nA = has_next ? (const char*)g.A + (size_t)nxt.pa * tstep + nxt.koff : cA; const char* nB = has_next ? (const char*)g.Bt + (size_t)nxt.pb * tstep + nxt.koff : cB;
        const int unt = cur.nt ? cur.nt : nt;
        for (int t = 0; t < unt; t += 2) {
            const bool last = (t == unt - 2);
            const char* a1 = cA + (size_t)(t + 1) * kstep;
            const char* a2 = last ? nA : cA + (size_t)(t + 2) * kstep; const char* b2 = last ? nB : cB + (size_t)(t + 2) * kstep;
            const char* a3 = a2 + kstep; const char* b3 = b2 + kstep;
            if (last && has_next) S.a_ready(nxt);
            if constexpr (SP2) {
            PG8_LDB(B0, 0, 0); PG8_LDB(B1, 0, 1); PG8_SCHED; PG8_LDA(At, 0, 0); PG8_STAGE(PG8_SA(1, 1), a1 + hstep, voffA);
            PG8_WAIT_V(8); PG8_WAIT_L(0); PG8_BAR; PG8_MMA(0, 0, At, B0); PG8_MMA(0, 1, At, B1); PG8_BAR; PG8_SCHED;
            PG8_LDA(At, 0, 1); PG8_STAGE(PG8_SB(0, 0), b2, voffB); PG8_STAGE(PG8_SB(0, 1), b2 + hstep, voffB); PG8_STAGE(PG8_SA(0, 0), a2, voffA);
            PG8_WAIT_V(8); PG8_WAIT_L(0); PG8_BAR; PG8_MMA(1, 0, At, B0); PG8_MMA(1, 1, At, B1); PG8_BAR; PG8_SCHED;
            PG8_LDB(B0, 1, 0); PG8_LDB(B1, 1, 1); PG8_SCHED; PG8_LDA(At, 1, 0); PG8_STAGE(PG8_SA(0, 1), a2 + hstep, voffA);
            PG8_WAIT_V(8); PG8_WAIT_L(0); PG8_BAR; PG8_MMA(0, 0, At, B0); PG8_MMA(0, 1, At, B1); PG8_BAR; PG8_SCHED;
            PG8_LDA(At, 1, 1); PG8_STAGE(PG8_SB(1, 0), b3, voffB); PG8_STAGE(PG8_SB(1, 1), b3 + hstep, voffB); PG8_STAGE(PG8_SA(1, 0), a3, voffA);
            PG8_WAIT_V(8); PG8_WAIT_L(0); PG8_BAR; PG8_MMA(1, 0, At, B0); PG8_MMA(1, 1, At, B1); PG8_BAR; PG8_SCHED;
            } else {
            PG8_LDB(B0, 0, 0); PG8_SCHED; PG8_LDA(At, 0, 0); PG8_STAGE(PG8_SA(1, 1), a1 + hstep, voffA);
            PG8_WAIT_L(8); PG8_BAR; PG8_WAIT_L(0); PG8_MMA(0, 0, At, B0); PG8_BAR; PG8_SCHED;
            PG8_LDB(B1, 0, 1); PG8_STAGE(PG8_SB(0, 0), b2, voffB);
            PG8_BAR; PG8_WAIT_L(0); PG8_MMA(0, 1, At, B1); PG8_BAR;
            PG8_LDA(At, 0, 1); PG8_STAGE(PG8_SA(0, 0), a2, voffA);
            PG8_BAR; PG8_WAIT_L(0); PG8_MMA(1, 0, At, B0); PG8_BAR; PG8_SCHED;
            PG8_STAGE(PG8_SB(0, 1), b2 + hstep, voffB);
            PG8_WAIT_V(6); PG8_BAR; PG8_MMA(1, 1, At, B1); PG8_BAR;
            PG8_LDB(B0, 1, 0); PG8_SCHED; PG8_LDA(At, 1, 0); PG8_STAGE(PG8_SA(0, 1), a2 + hstep, voffA);
            PG8_WAIT_L(8); PG8_BAR; PG8_WAIT_L(0); PG8_MMA(0, 0, At, B0); PG8_BAR; PG8_SCHED;
            PG8_LDB(B1, 1, 1); PG8_STAGE(PG8_SB(1, 0), b3, voffB);
            PG8_BAR; PG8_WAIT_L(0); PG8_MMA(0, 1, At, B1); PG8_BAR;
            PG8_LDA(At, 1, 1); PG8_STAGE(PG8_SA(1, 0), a3, voffA);
            PG8_BAR; PG8_WAIT_L(0); PG8_MMA(1, 0, At, B0); PG8_BAR; PG8_SCHED;
            PG8_STAGE(PG8_SB(1, 1), b3 + hstep, voffB);
            PG8_WAIT_V(6); PG8_BAR; PG8_MMA(1, 1, At, B1); PG8_BAR;
            }
        }
        if constexpr (ALIGN_EPI) { if (wr == 0) PG8_BAR; }
        if constexpr (!Epi::AFTER_DRAIN) { E(acc, cur, wr, wc, fr, fq); S.done(cur); }
        if (!has_next) break;
#pragma unroll
        for (int a = 0; a < 2; ++a)
#pragma unroll
            for (int b = 0; b < 2; ++b)
#pragma unroll
                for (int m = 0; m < 4; ++m)
#pragma unroll
                    for (int n = 0; n < 2; ++n) acc[a][b][m][n] = (f32x4){0.f, 0.f, 0.f, 0.f};
        cur = nxt; cA = nA; cB = nB; ++ui;
        if constexpr (ALIGN_EPI) { if (wr == 1) PG8_BAR; }
    }
    PG8_WAIT_V(0);
    if constexpr (!ALIGN_EPI) { if (wr == 0) PG8_BAR; }
    PG8_BAR;
    if constexpr (Epi::AFTER_DRAIN) { E.fused(acc, cur, wr, wc, fr, fq, lds, wid, lane); S.done(cur); }
#undef PG8_SA
#undef PG8_SB
#undef PG8_STAGE
#undef PG8_LDA
#undef PG8_LDB
#undef PG8_MMA
#undef PG8_WAIT_V
#undef PG8_WAIT_L
#undef PG8_BAR
#undef PG8_SCHED
}
}
#ifndef REPMASK
#define REPMASK 0
#endif
#define LAS __attribute__((address_space(3)))
#define CAS __attribute__((address_space(4)))
typedef unsigned short bf16_t;
typedef short bf16x8 __attribute__((ext_vector_type(8)));
typedef float f32x4 __attribute__((ext_vector_type(4)));
typedef unsigned u32x4 __attribute__((ext_vector_type(4)));
typedef unsigned u32x2 __attribute__((ext_vector_type(2)));

constexpr int DM = 1024, NBATCH = 8, SEQ = 2048, DEPTH = 2, DBATCH = 128, DSEQ = 8;
constexpr int MP = NBATCH * SEQ, MS = DBATCH * DSEQ, M = MP + MS;
constexpr int IN_DIM = 4352, ATT = 512, CD = 512, FF = 4096;
constexpr int ZP = IN_DIM;
constexpr int ZQ = 0, ZK = 512, ZV = 640, ZB = 768, ZC = 1280, ZU = 1792, ZGA = 2304;
constexpr float EPS = 1e-6f;
constexpr float LOG2E = 1.4426950408889634f;

constexpr size_t O_Y = 0;
constexpr size_t O_KP = (size_t)M * DM;
constexpr size_t O_VP = O_KP + 2 * 8 * 128 * 128;
constexpr size_t O_CP = O_VP + 2 * 8 * 128 * 128;
constexpr size_t O_KS = O_CP + 2 * 8 * 2 * 512;
constexpr size_t O_VS = O_KS + (size_t)2 * 128 * 128 * 128;
constexpr size_t O_CS = O_VS + (size_t)2 * 128 * 128 * 128;

constexpr size_t MiB = 1u << 20;
constexpr size_t WS_R = 0;
constexpr size_t WS_BAR = 512 * 1024;
constexpr size_t WS_W = 3 * MiB;
constexpr size_t W_IN = 0, W_BR = W_IN + (size_t)IN_DIM * DM, W_OUT = W_BR + (size_t)2048 * 512, W_UP = W_OUT + (size_t)DM * DM, W_DN = W_UP + (size_t)FF * DM, W_END = W_DN + (size_t)DM * FF;
constexpr size_t WS_Z = 32 * MiB;
constexpr size_t WS_S1 = 177 * MiB;
constexpr size_t WS_S2 = 211 * MiB;
constexpr size_t WS_END = 247 * MiB;
constexpr int NSL = 8;
static_assert(WS_W + W_END * 2 <= WS_Z && WS_Z + (size_t)M * ZP * 2 <= WS_S1 && WS_S1 + (size_t)M * DM * 2 <= WS_S2 && WS_S2 + (size_t)(M + 1024) * DM * 2 <= WS_END, "ws map");

constexpr int LDS_BYTES = 147456;
constexpr int NTHREADS = 512, NWAVES = 8;

__device__ __forceinline__ float bf2f(unsigned b) { return __uint_as_float(b << 16); }
typedef float f32x2_t __attribute__((ext_vector_type(2))); typedef __bf16 bf16x2_t __attribute__((ext_vector_type(2)));
__device__ __forceinline__ unsigned pk2(float lo, float hi) { const f32x2_t v = {lo, hi}; const bf16x2_t b = __builtin_convertvector(v, bf16x2_t); return __builtin_bit_cast(unsigned, b); }
__device__ __forceinline__ float wave_sum(float v) {
#pragma unroll
    for (int o = 1; o < 64; o <<= 1) v += __shfl_xor(v, o);
    return v;
}
__device__ __forceinline__ void unpack8(const u32x4 v, float (&f)[8]) {
    f[0] = bf2f(v.x & 0xffffu); f[1] = __uint_as_float(v.x & 0xffff0000u); f[2] = bf2f(v.y & 0xffffu); f[3] = __uint_as_float(v.y & 0xffff0000u);
    f[4] = bf2f(v.z & 0xffffu); f[5] = __uint_as_float(v.z & 0xffff0000u); f[6] = bf2f(v.w & 0xffffu); f[7] = __uint_as_float(v.w & 0xffff0000u);
}
__device__ __forceinline__ u32x4 pack8(const float (&f)[8]) { u32x4 w; w.x = pk2(f[0], f[1]); w.y = pk2(f[2], f[3]); w.z = pk2(f[4], f[5]); w.w = pk2(f[6], f[7]); return w; }
__device__ __forceinline__ float sigmoidf_fast(float x) { return __builtin_amdgcn_rcpf(1.0f + __builtin_amdgcn_exp2f(-x * LOG2E)); }

template <int MODE> struct Epi {
    static constexpr bool PERM = true, AFTER_DRAIN = false;
    bf16_t* O; int ldc; const float* r; const bf16_t* Z; float* part;
    __device__ __forceinline__ void operator()(const f32x4 (&acc)[2][2][4][2], const pg8::Unit& u, int wr, int wc, int fr, int fq) const {
        const int row0 = u.pm * 256 + wr * 64 + fr, col0 = u.pn * 256 + wc * 32 + 8 * fq;
#pragma unroll
        for (int ai = 0; ai < 2; ++ai)
#pragma unroll
            for (int m = 0; m < 4; ++m) {
                const int row = row0 + ai * 128 + m * 16;
                float rs = 1.f;
                if (MODE == 1 || MODE == 6) rs = r[row];
#pragma unroll
                for (int bj = 0; bj < 2; ++bj) {
                    const int col = col0 + bj * 128;
                    const f32x4 a0 = acc[ai][bj][m][0], a1 = acc[ai][bj][m][1];
                    float v[8] = {a0[0], a0[1], a0[2], a0[3], a1[0], a1[1], a1[2], a1[3]};
                    if (MODE == 4 && u.pm >= MP / 256) {
                        float* pd = part + ((size_t)u.w * MS + (row - MP)) * DM + col;
                        *(f32x4*)pd = a0; *(f32x4*)(pd + 4) = a1; continue; }
                    bf16_t* dst = O + (size_t)(row + ((MODE == 3 && u.pm >= MP / 256) ? u.w * MS : 0)) * ldc + col;
                    if (MODE == 1) {
#pragma unroll
                        for (int e = 0; e < 8; ++e) v[e] *= rs;
                        if (u.pn >= 9) {
#pragma unroll
                            for (int e = 0; e < 8; ++e) v[e] = sigmoidf_fast(v[e]);
                        }
                    } else if (MODE == 3) {
                        float gt[8]; unpack8(*(const u32x4*)(Z + (size_t)row * ZP + ZGA + u.w * 1024 + col), gt);
#pragma unroll
                        for (int e = 0; e < 8; ++e) v[e] *= gt[e];
                        if (u.w == 1 && u.pm < MP / 256) { float t[8]; unpack8(*(const u32x4*)dst, t);
#pragma unroll
                            for (int e = 0; e < 8; ++e) v[e] += t[e]; }
                    } else if (MODE == 6) {
#pragma unroll
                        for (int e = 0; e < 8; ++e) { const float q = fmaxf(v[e] * rs, 0.f); v[e] = q * q; }
                    }
                    *(u32x4*)dst = pack8(v);
                }
            }
    }
};

struct PairOrder {
    pg8::StaticOrder so; int c;
    __device__ __forceinline__ void init(int G_, int c_) { so.init(MP, DM, G_, c_); c = c_; }
    __device__ __forceinline__ bool next(int i, pg8::Unit& u) const {
        const int np = (so.nwg - c + so.G - 1) / so.G;
        pg8::Unit t; t.pm = 0; t.pn = 0; t.pa = 0; t.pb = 0; t.w = 0; t.koff = 0; t.nt = 0;
        bool ok;
        if (i < 2 * np) { ok = so.next(i >> 1, t); t.w = i & 1; }
        else { const int j = (i - 2 * np) * so.G + c; ok = j < 32; t.pm = MP / 256 + ((j >> 3) & 3); t.pn = (j >> 1) & 3; t.w = j & 1; }
        t.koff = 0; t.nt = 0; t.pa = t.w * (M / 256) + t.pm; t.pb = t.w * 4 + t.pn; u = t; return ok; }
    __device__ __forceinline__ void a_ready(const pg8::Unit&) const {}
    __device__ __forceinline__ void done(const pg8::Unit&) const {}
};
struct SliceOrder {
    pg8::StaticOrder so; int c, ntl, wrapk;
    __device__ __forceinline__ void init(int G_, int c_, int ntl_, int wrapk_) { so.init(MP, DM, G_, c_); c = c_; ntl = ntl_; wrapk = wrapk_; }
    __device__ __forceinline__ bool next(int i, pg8::Unit& u) const {
        const int nsl = (c < 16 * NSL) ? (16 * NSL - c + so.G - 1) / so.G : 0;
        pg8::Unit t; t.pm = 0; t.pn = 0; t.pa = 0; t.pb = 0; t.w = 0; t.koff = 0; t.nt = 0;
        bool ok;
        if (i < nsl) { const int j = i * so.G + c, tile = j / NSL, s = j % NSL, kt0 = s * ntl, src = kt0 / wrapk; ok = true;
            t.pm = MP / 256 + (tile >> 2); t.pn = tile & 3; t.w = s; t.pa = MP / 256 + src * 4 + (tile >> 2); t.pb = t.pn; t.koff = (kt0 % wrapk) * 128; t.nt = ntl; }
        else ok = so.next(i - nsl, t);
        u = t; return ok; }
    __device__ __forceinline__ void a_ready(const pg8::Unit&) const {}
    __device__ __forceinline__ void done(const pg8::Unit&) const {}
};

__device__ __forceinline__ void transpose_item(const float* W, const float* gk, int K, int N, bf16_t* WT, int row_off, LAS float* scr, int item, int lane) {
    const int nblk = N / 32, kb = item / nblk, nb = item % nblk, k0 = 64 * kb, n0 = 32 * nb;
    float wv[32];
#pragma unroll
    for (int i = 0; i < 32; ++i) { const int kk = 2 * i + (lane >> 5); wv[i] = W[(size_t)(k0 + kk) * N + n0 + (lane & 31)]; }
    if (gk) {
#pragma unroll
        for (int i = 0; i < 32; ++i) wv[i] *= gk[k0 + 2 * i + (lane >> 5)];
    }
#pragma unroll
    for (int i = 0; i < 32; ++i) { const int kk = 2 * i + (lane >> 5); scr[kk * 33 + (lane & 31)] = wv[i]; }
    asm volatile("s_waitcnt lgkmcnt(0)" ::: "memory");
    const int c = lane & 7;
#pragma unroll
    for (int j = 0; j < 4; ++j) { const int n = (lane >> 3) + 8 * j; const LAS float* s = scr + (8 * c) * 33 + n;
        u32x4 o; o.x = pk2(s[0 * 33], s[1 * 33]); o.y = pk2(s[2 * 33], s[3 * 33]); o.z = pk2(s[4 * 33], s[5 * 33]); o.w = pk2(s[6 * 33], s[7 * 33]);
        *(u32x4*)(WT + (size_t)(row_off + n0 + n) * K + k0 + 8 * c) = o; }
    asm volatile("s_waitcnt lgkmcnt(0)" ::: "memory");
}
struct Args { const float* in[17]; float* out; unsigned char* ws; };

__device__ __forceinline__ void convert_weights(const Args& a, int l, bf16_t* Wb, LAS unsigned char* lds, int gw, int NGW, int wave, int lane) {
    LAS float* scr = (LAS float*)(lds + wave * 16384);
    constexpr int I_IN = 16 * 136, I_AO = 8 * 32, I_CO = 8 * 32, I_OUT = 16 * 32, I_UP = 16 * 128, I_DN = 64 * 32;
    constexpr int NITEMS = I_IN + I_AO + I_CO + I_OUT + I_UP + I_DN;
    const float* w_in = a.in[9] + (size_t)l * DM * IN_DIM; const float* w_ao = a.in[12] + (size_t)l * ATT * DM; const float* w_co = a.in[13] + (size_t)l * CD * DM;
    const float* w_out = a.in[14] + (size_t)l * DM * DM; const float* w_up = a.in[15] + (size_t)l * DM * FF; const float* w_dn = a.in[16] + (size_t)l * FF * DM;
    const float* g_pre = a.in[5] + l * DM; const float* g_mlp = a.in[7] + l * DM;
    for (int it = gw; it < NITEMS; it += NGW) {
        int r = it;
        if (r < I_IN) { transpose_item(w_in, g_pre, DM, IN_DIM, Wb + W_IN, 0, scr, r, lane); continue; } r -= I_IN;
        if (r < I_AO) { transpose_item(w_ao, nullptr, ATT, DM, Wb + W_BR, 0, scr, r, lane); continue; } r -= I_AO;
        if (r < I_CO) { transpose_item(w_co, nullptr, CD, DM, Wb + W_BR, 1024, scr, r, lane); continue; } r -= I_CO;
        if (r < I_OUT) { transpose_item(w_out, nullptr, DM, DM, Wb + W_OUT, 0, scr, r, lane); continue; } r -= I_OUT;
        if (r < I_UP) { transpose_item(w_up, g_mlp, DM, FF, Wb + W_UP, 0, scr, r, lane); continue; } r -= I_UP;
        transpose_item(w_dn, nullptr, FF, DM, Wb + W_DN, 0, scr, r, lane);
    }
}

__device__ __forceinline__ void rows_prologue(const float* xp, const float* xs, bf16_t* xb, float* r, int gw, int NGW, int lane) {
    for (int row0 = gw; row0 < M; row0 += 4 * NGW) {
        f32x4 v[4][4];
#pragma unroll
        for (int b = 0; b < 4; ++b) { const int row = row0 + b * NGW;
            if (row < M) { const float* xr = (row < MP) ? xp + (size_t)row * DM : xs + (size_t)(row - MP) * DM;
#pragma unroll
                for (int j = 0; j < 4; ++j) v[b][j] = *(const f32x4*)(xr + 4 * lane + 256 * j); } }
#pragma unroll
        for (int b = 0; b < 4; ++b) { const int row = row0 + b * NGW;
            if (row < M) { float ss = 0.f;
#pragma unroll
                for (int j = 0; j < 4; ++j) ss += (v[b][j][0] * v[b][j][0] + v[b][j][1] * v[b][j][1]) + (v[b][j][2] * v[b][j][2] + v[b][j][3] * v[b][j][3]);
                ss = wave_sum(ss);
#pragma unroll
                for (int j = 0; j < 4; ++j) { u32x2 w; w.x = pk2(v[b][j][0], v[b][j][1]); w.y = pk2(v[b][j][2], v[b][j][3]); *(u32x2*)(xb + (size_t)row * DM + 4 * lane + 256 * j) = w; }
                if (lane == 0) r[row] = 1.0f / sqrtf(ss * (1.0f / DM) + EPS); } }
    }
}
constexpr int RB = 4;
template <bool XF32, bool WY>
__device__ __forceinline__ void rows_residual(const bf16_t* src, const float* part, const float* xin_p, const float* xin_s, const bf16_t* xin_b, const float* g, float* yout, bf16_t* xb, float* r, int rb, int re, int gw, int NGW, int lane) {
    f32x4 gv[4];
#pragma unroll
    for (int j = 0; j < 4; ++j) gv[j] = *(const f32x4*)(g + 4 * lane + 256 * j);
    for (int row0 = rb + gw; row0 < re; row0 += RB * NGW) {
        f32x4 s[RB][4], x[RB][4];
#pragma unroll
        for (int b = 0; b < RB; ++b) {
            const int row = row0 + b * NGW;
            if (row < re) {
#pragma unroll
                for (int j = 0; j < 4; ++j) {
                    if (XF32) { const float* xr = (row < MP) ? xin_p + (size_t)row * DM : xin_s + (size_t)(row - MP) * DM; x[b][j] = *(const f32x4*)(xr + 4 * lane + 256 * j); }
                    else { const u32x2 w = *(const u32x2*)(xin_b + (size_t)row * DM + 4 * lane + 256 * j);
                        x[b][j][0] = bf2f(w.x & 0xffffu); x[b][j][1] = __uint_as_float(w.x & 0xffff0000u); x[b][j][2] = bf2f(w.y & 0xffffu); x[b][j][3] = __uint_as_float(w.y & 0xffff0000u); }
                    if (row < MP) { const u32x2 w = *(const u32x2*)(src + (size_t)row * DM + 4 * lane + 256 * j);
                        s[b][j][0] = bf2f(w.x & 0xffffu); s[b][j][1] = __uint_as_float(w.x & 0xffff0000u); s[b][j][2] = bf2f(w.y & 0xffffu); s[b][j][3] = __uint_as_float(w.y & 0xffff0000u); }
                    else { const float* pp = part + (size_t)(row - MP) * DM + 4 * lane + 256 * j; s[b][j] = *(const f32x4*)pp;
#pragma unroll
                        for (int q = 1; q < NSL; ++q) s[b][j] += *(const f32x4*)(pp + (size_t)q * MS * DM); } }
            }
        }
#pragma unroll
        for (int b = 0; b < RB; ++b) {
            const int row = row0 + b * NGW;
            if (row < re) {
                float ss = 0.f;
#pragma unroll
                for (int j = 0; j < 4; ++j) ss += (s[b][j][0] * s[b][j][0] + s[b][j][1] * s[b][j][1]) + (s[b][j][2] * s[b][j][2] + s[b][j][3] * s[b][j][3]);
                ss = wave_sum(ss);
                const float rm = 1.0f / sqrtf(ss * (1.0f / DM) + EPS);
#pragma unroll
                for (int j = 0; j < 4; ++j) x[b][j] = x[b][j] + s[b][j] * rm * gv[j];
                if (WY) {
#pragma unroll
                    for (int j = 0; j < 4; ++j) *(f32x4*)(yout + (size_t)row * DM + 4 * lane + 256 * j) = x[b][j];
                } else {
                    float s2 = 0.f;
#pragma unroll
                    for (int j = 0; j < 4; ++j) { u32x2 w; w.x = pk2(x[b][j][0], x[b][j][1]); w.y = pk2(x[b][j][2], x[b][j][3]); *(u32x2*)(xb + (size_t)row * DM + 4 * lane + 256 * j) = w;
                        const float q0 = bf2f(w.x & 0xffffu), q1 = __uint_as_float(w.x & 0xffff0000u), q2 = bf2f(w.y & 0xffffu), q3 = __uint_as_float(w.y & 0xffff0000u);
                        s2 += (q0 * q0 + q1 * q1) + (q2 * q2 + q3 * q3); }
                    s2 = wave_sum(s2);
                    if (lane == 0) r[row] = 1.0f / sqrtf(s2 * (1.0f / DM) + EPS);
                }
            }
        }
    }
}

constexpr int KS_STRIDE = 72, VT_STRIDE = 264;
constexpr int VT_OFF = 256 * KS_STRIDE * 2;
constexpr float SC_L2 = 0.125f * LOG2E;

template <bool SAMPLE>
__device__ __forceinline__ void attn_qtile(const LAS unsigned char* lds, const bf16_t* Z, bf16_t* AO, int qrow, int head, int iq, int tb, bool has_prev, float sink_l2, int lane) {
    const int q = lane & 15, g = lane >> 4;
    const bf16x8 qf0 = *(const bf16x8*)(Z + (size_t)qrow * ZP + ZQ + head * 64 + 8 * g);
    const bf16x8 qf1 = *(const bf16x8*)(Z + (size_t)qrow * ZP + ZQ + head * 64 + 32 + 8 * g);
    f32x4 s[10];
    const LAS unsigned char* kbase = lds + ((tb * 16 + q) * KS_STRIDE + 8 * g) * 2;
    const int lo1 = (!SAMPLE && !has_prev && iq < 127) ? 128 : iq + 1;
    const unsigned span = (unsigned)(iq + 128 - lo1);
    const int d0 = tb * 16 + 4 * g - lo1;
    float mx = sink_l2;
#pragma unroll
    for (int t = 0; t < 10; ++t) {
        const bf16x8 a0 = *(const LAS bf16x8*)(kbase + t * 16 * KS_STRIDE * 2);
        const bf16x8 a1 = *(const LAS bf16x8*)(kbase + t * 16 * KS_STRIDE * 2 + 64);
        f32x4 z = {0.f, 0.f, 0.f, 0.f};
        z = __builtin_amdgcn_mfma_f32_16x16x32_bf16(a0, qf0, z, 0, 0, 0);
        z = __builtin_amdgcn_mfma_f32_16x16x32_bf16(a1, qf1, z, 0, 0, 0);
#pragma unroll
        for (int j = 0; j < 4; ++j) {
            const bool vis = (unsigned)(d0 + t * 16 + j) <= span;
            const float v = vis ? z[j] * SC_L2 : -INFINITY;
            z[j] = v; mx = fmaxf(mx, v);
        }
        s[t] = z;
    }
    mx = fmaxf(mx, __shfl_xor(mx, 16)); mx = fmaxf(mx, __shfl_xor(mx, 32));
    float sum = 0.f;
#pragma unroll
    for (int t = 0; t < 10; ++t)
#pragma unroll
        for (int j = 0; j < 4; ++j) { const float p = __builtin_amdgcn_exp2f(s[t][j] - mx); s[t][j] = p; sum += p; }
    sum += __shfl_xor(sum, 16); sum += __shfl_xor(sum, 32);
    sum += __builtin_amdgcn_exp2f(sink_l2 - mx);
    const float inv = 1.0f / sum;
    bf16x8 pf[5];
#pragma unroll
    for (int c = 0; c < 5; ++c) {
        u32x4 w; w.x = pk2(s[2 * c][0] * inv, s[2 * c][1] * inv); w.y = pk2(s[2 * c][2] * inv, s[2 * c][3] * inv);
        w.z = pk2(s[2 * c + 1][0] * inv, s[2 * c + 1][1] * inv); w.w = pk2(s[2 * c + 1][2] * inv, s[2 * c + 1][3] * inv);
        pf[c] = __builtin_bit_cast(bf16x8, w);
    }
    f32x4 o[4];
#pragma unroll
    for (int dt = 0; dt < 4; ++dt) o[dt] = (f32x4){0.f, 0.f, 0.f, 0.f};
    const LAS unsigned char* vbase = lds + VT_OFF + (q * VT_STRIDE + tb * 16 + 4 * g) * 2;
#pragma unroll
    for (int c = 0; c < 5; ++c)
#pragma unroll
        for (int dt = 0; dt < 4; ++dt) {
            const u32x2 lo = *(const LAS u32x2*)(vbase + dt * 16 * VT_STRIDE * 2 + c * 64);
            const u32x2 hi = *(const LAS u32x2*)(vbase + dt * 16 * VT_STRIDE * 2 + c * 64 + 32);
            const u32x4 av = {lo.x, lo.y, hi.x, hi.y};
            o[dt] = __builtin_amdgcn_mfma_f32_16x16x32_bf16(__builtin_bit_cast(bf16x8, av), pf[c], o[dt], 0, 0, 0);
        }
#pragma unroll
    for (int dt = 0; dt < 4; ++dt) { u32x2 w; w.x = pk2(o[dt][0], o[dt][1]); w.y = pk2(o[dt][2], o[dt][3]);
        *(u32x2*)(AO + (size_t)qrow * ATT + head * 64 + dt * 16 + 4 * g) = w; }
}

__device__ __forceinline__ void lds_put_kv(LAS unsigned char* lds, int key, int ch, u32x4 kv, u32x4 vv) {
    *(LAS u32x4*)(lds + key * (KS_STRIDE * 2) + ch * 16) = kv;
    LAS unsigned short* vt = (LAS unsigned short*)(lds + VT_OFF) + (ch * 8) * VT_STRIDE + key;
    vt[0 * VT_STRIDE] = (unsigned short)(vv.x & 0xffffu); vt[1 * VT_STRIDE] = (unsigned short)(vv.x >> 16);
    vt[2 * VT_STRIDE] = (unsigned short)(vv.y & 0xffffu); vt[3 * VT_STRIDE] = (unsigned short)(vv.y >> 16);
    vt[4 * VT_STRIDE] = (unsigned short)(vv.z & 0xffffu); vt[5 * VT_STRIDE] = (unsigned short)(vv.z >> 16);
    vt[6 * VT_STRIDE] = (unsigned short)(vv.w & 0xffffu); vt[7 * VT_STRIDE] = (unsigned short)(vv.w >> 16);
}
__device__ __forceinline__ void store8f(float* dst, const u32x4 v) { float f[8]; unpack8(v, f); *(f32x4*)dst = (f32x4){f[0], f[1], f[2], f[3]}; *(f32x4*)(dst + 4) = (f32x4){f[4], f[5], f[6], f[7]}; }

__device__ __forceinline__ void attn_prompt_unit(const Args& a, int l, int unit, const bf16_t* Z, bf16_t* AO, LAS unsigned char* lds, int tid, int wave, int lane) {
    const int b = unit >> 5, qb = (unit >> 1) & 15, kvh = unit & 1;
    const int rowbase = b * SEQ + qb * 128;
    const bool has_prev = qb > 0;
#pragma unroll
    for (int i = 0; i < 4; ++i) {
        const int item = tid + NTHREADS * i, key = item >> 3, ch = item & 7;
        u32x4 kv = {0u, 0u, 0u, 0u}, vv = {0u, 0u, 0u, 0u};
        if (has_prev || key >= 128) {
            const bf16_t* zr = Z + (size_t)(rowbase - 128 + key) * ZP + kvh * 64 + ch * 8;
            kv = *(const u32x4*)(zr + ZK); vv = *(const u32x4*)(zr + ZV);
            if (qb == 15 && key >= 128) {
                const size_t o = (((size_t)(l * NBATCH + b) * 128 + (key - 128)) * 2 + kvh) * 64 + ch * 8;
                store8f(a.out + O_KP + o, kv); store8f(a.out + O_VP + o, vv);
            }
        }
        lds_put_kv(lds, key, ch, kv, vv);
    }
    __syncthreads();
    const int hh = wave >> 1, half = wave & 1, head = kvh * 4 + hh;
    const float sink_l2 = a.in[10][l * 8 + head] * LOG2E;
#pragma unroll 1
    for (int qt = 0; qt < 4; ++qt) {
        const int iq0 = half * 64 + qt * 16, iq = iq0 + (lane & 15);
        attn_qtile<false>(lds, Z, AO, rowbase + iq, head, iq, (iq0 >> 4) & ~1, has_prev, sink_l2, lane);
    }
    __syncthreads();
}
__device__ __forceinline__ void attn_sample_unit(const Args& a, int l, int unit, const bf16_t* Z, bf16_t* AO, LAS unsigned char* lds, int tid, int wave, int lane) {
    const int n = unit >> 1, kvh = unit & 1;
    const float* ck = a.in[2] + ((size_t)(l * DBATCH + n) * 128) * 128 + kvh * 64;
    const float* cv = a.in[3] + ((size_t)(l * DBATCH + n) * 128) * 128 + kvh * 64;
#pragma unroll
    for (int i = 0; i < 3; ++i) {
        const int item = tid + NTHREADS * i, key = item >> 3, ch = item & 7;
        if (item < 160 * 8) {
            u32x4 kv = {0u, 0u, 0u, 0u}, vv = {0u, 0u, 0u, 0u};
            const size_t o = (((size_t)(l * DBATCH + n) * 128 + (key - 8)) * 2 + kvh) * 64 + ch * 8;
            if (key < 128) {
                const f32x4 k0 = *(const f32x4*)(ck + (size_t)key * 128 + ch * 8), k1 = *(const f32x4*)(ck + (size_t)key * 128 + ch * 8 + 4);
                const f32x4 v0 = *(const f32x4*)(cv + (size_t)key * 128 + ch * 8), v1 = *(const f32x4*)(cv + (size_t)key * 128 + ch * 8 + 4);
                kv = (u32x4){pk2(k0[0], k0[1]), pk2(k0[2], k0[3]), pk2(k1[0], k1[1]), pk2(k1[2], k1[3])};
                vv = (u32x4){pk2(v0[0], v0[1]), pk2(v0[2], v0[3]), pk2(v1[0], v1[1]), pk2(v1[2], v1[3])};
                if (key >= 8) { *(f32x4*)(a.out + O_KS + o) = k0; *(f32x4*)(a.out + O_KS + o + 4) = k1; *(f32x4*)(a.out + O_VS + o) = v0; *(f32x4*)(a.out + O_VS + o + 4) = v1; }
            } else if (key < 136) {
                const bf16_t* zr = Z + (size_t)(MP + n * DSEQ + (key - 128)) * ZP + kvh * 64 + ch * 8;
                kv = *(const u32x4*)(zr + ZK); vv = *(const u32x4*)(zr + ZV);
                store8f(a.out + O_KS + o, kv); store8f(a.out + O_VS + o, vv);
            }
            lds_put_kv(lds, key, ch, kv, vv);
        }
    }
    __syncthreads();
    if (wave < 2) {
        const int q = lane & 15, head = kvh * 4 + wave * 2 + (q >> 3), t = q & 7;
        const float sink_l2 = a.in[10][l * 8 + head] * LOG2E;
        attn_qtile<true>(lds, Z, AO, MP + n * DSEQ + t, head, t, 0, true, sink_l2, lane);
    }
    __syncthreads();
}

__device__ __forceinline__ void conv_phase(const Args& a, int l, const bf16_t* Z, bf16_t* BZ, int gtid, int nth) {
    const float* cw = a.in[11] + (size_t)l * 3 * CD;
    for (int item = gtid; item < (M / 4) * 64; item += nth) {
        const int row0 = (item >> 6) * 4, c0 = (item & 63) * 8;
        const bool smp = row0 >= MP;
        const int t0 = smp ? ((row0 - MP) & 7) : (row0 & (SEQ - 1));
        const int n = smp ? ((row0 - MP) >> 3) : (row0 >> 11);
        const bf16_t* zr = Z + (size_t)row0 * ZP + c0;
        u32x4 rB[4], rC[6], rU[6];
#pragma unroll
        for (int i = 0; i < 4; ++i) { rB[i] = *(const u32x4*)(zr + (size_t)i * ZP + ZB); rC[i + 2] = *(const u32x4*)(zr + (size_t)i * ZP + ZC); rU[i + 2] = *(const u32x4*)(zr + (size_t)i * ZP + ZU); }
        float up[6][8];
        if (t0 > 0) {
#pragma unroll
            for (int i = 0; i < 2; ++i) { rC[i] = *(const u32x4*)(zr - (size_t)(2 - i) * ZP + ZC); rU[i] = *(const u32x4*)(zr - (size_t)(2 - i) * ZP + ZU); }
#pragma unroll
            for (int i = 0; i < 2; ++i) { float cv[8], uv[8]; unpack8(rC[i], cv); unpack8(rU[i], uv);
#pragma unroll
                for (int e = 0; e < 8; ++e) up[i][e] = cv[e] * uv[e]; }
        } else if (smp) {
#pragma unroll
            for (int i = 0; i < 2; ++i) { const float* sp = a.in[4] + ((size_t)(l * DBATCH + n) * 2 + i) * CD + c0;
#pragma unroll
                for (int e = 0; e < 8; ++e) up[i][e] = sp[e]; }
        } else {
#pragma unroll
            for (int i = 0; i < 2; ++i)
#pragma unroll
                for (int e = 0; e < 8; ++e) up[i][e] = 0.f;
        }
#pragma unroll
        for (int i = 2; i < 6; ++i) { float cv[8], uv[8]; unpack8(rC[i], cv); unpack8(rU[i], uv);
#pragma unroll
            for (int e = 0; e < 8; ++e) up[i][e] = cv[e] * uv[e]; }
        float w0[8], w1[8], w2[8];
#pragma unroll
        for (int e = 0; e < 8; ++e) { w0[e] = cw[c0 + e]; w1[e] = cw[CD + c0 + e]; w2[e] = cw[2 * CD + c0 + e]; }
        const int tl = smp ? DSEQ : SEQ;
#pragma unroll
        for (int i = 0; i < 4; ++i) {
            float bv[8], o[8]; unpack8(rB[i], bv);
#pragma unroll
            for (int e = 0; e < 8; ++e) o[e] = bv[e] * (w0[e] * up[i][e] + w1[e] * up[i + 1][e] + w2[e] * up[i + 2][e]);
            *(u32x4*)(BZ + (size_t)(row0 + i) * CD + c0) = pack8(o);
            if (i >= 2 && t0 + 4 == tl) {
                float* dst = smp ? a.out + O_CS + ((size_t)(l * DBATCH + n) * 2 + (i - 2)) * CD + c0 : a.out + O_CP + ((size_t)(l * NBATCH + n) * 2 + (i - 2)) * CD + c0;
                *(f32x4*)dst = (f32x4){up[i + 2][0], up[i + 2][1], up[i + 2][2], up[i + 2][3]}; *(f32x4*)(dst + 4) = (f32x4){up[i + 2][4], up[i + 2][5], up[i + 2][6], up[i + 2][7]};
            }
        }
    }
}

#define RLX_AGENT __ATOMIC_RELAXED, __HIP_MEMORY_SCOPE_AGENT
#define XB_TMO      128
#define XB_XCNT(j)  (256  + 64 * (j))
#define XB_XSUB(j)  (1280 + 64 * (j))
#define XB_XGEN(j)  (2304 + 64 * (j))
#define XB_TOP      3328
#define XB_TOPGEN   3392
#define XCD_BAR_WORDS 3456
#define XB_SPIN_CAP (1u << 18)

__device__ __forceinline__ unsigned xb_ld(unsigned* p)              { return __hip_atomic_load(p, __ATOMIC_RELAXED, __HIP_MEMORY_SCOPE_AGENT); }
__device__ __forceinline__ unsigned xb_add(unsigned* p, unsigned v) { return __hip_atomic_fetch_add(p, v, __ATOMIC_RELAXED, __HIP_MEMORY_SCOPE_AGENT); }
__device__ __forceinline__ unsigned xb_xcc_id() { return (unsigned)__builtin_amdgcn_s_getreg((3 << 11) | 20) & 0xFu; }
#define XB_SPIN(cond, bar) do { unsigned _sp = 0; while (cond) { __builtin_amdgcn_s_sleep(1); \
    if ((++_sp & 255u) == 0u) { if (xb_ld(&(bar)[XB_TMO])) break; if (_sp > XB_SPIN_CAP) { atomicAdd(&(bar)[XB_TMO], 1u); break; } } } } while (0)

struct XcdBarrier {
    unsigned* bar; unsigned x;
    volatile LAS unsigned* st;
};

__device__ __forceinline__ XcdBarrier xcd_barrier_post(unsigned* bar, volatile LAS unsigned* st) {
    XcdBarrier b; b.bar = bar; b.x = xb_xcc_id(); b.st = st;
    if (threadIdx.x == 0) (void)xb_add(&bar[XB_XCNT(b.x)], 1u);
    return b;
}
__device__ __forceinline__ void xcd_barrier_complete(unsigned* bar, unsigned x, unsigned& nloc, unsigned& nx) {
    const unsigned G = gridDim.x * gridDim.y * gridDim.z;
    unsigned sum, cnt, mine, sp = 0u;
    for (;;) {
        sum = 0u; cnt = 0u; mine = 0u;
#pragma unroll
        for (unsigned j = 0; j < 16; ++j) { const unsigned c = xb_ld(&bar[XB_XCNT(j)]); sum += c; cnt += (c > 0u) ? 1u : 0u; mine = (j == x) ? c : mine; }
        if (sum == G) break;
        __builtin_amdgcn_s_sleep(1);
        if ((++sp & 255u) == 0u) { if (xb_ld(&bar[XB_TMO])) break; if (sp > XB_SPIN_CAP) { atomicAdd(&bar[XB_TMO], 1u); break; } }
    }
    nloc = mine > 0u ? mine : 1u; nx = cnt > 0u ? cnt : 1u;
}

__device__ __forceinline__ void xcd_barrier(const XcdBarrier& b) {
    asm volatile("s_waitcnt vmcnt(0)" ::: "memory");
    __syncthreads();
    if (threadIdx.x == 0) {
        unsigned* bar = b.bar;
        __builtin_amdgcn_s_waitcnt(0);
        unsigned nloc = b.st[0], nx = b.st[1];
        if (nloc == 0u) { xcd_barrier_complete(bar, b.x, nloc, nx); b.st[0] = nloc; b.st[1] = nx; }
        const unsigned old = xb_add(&bar[XB_XSUB(b.x)], 1u);
        const unsigned gen = old / nloc;
        if (old + 1u == (gen + 1u) * nloc) {
            __builtin_amdgcn_fence(__ATOMIC_RELEASE, "agent");
            asm volatile("s_waitcnt vmcnt(0)" ::: "memory");
            const unsigned og = xb_add(&bar[XB_TOP], 1u);
            const unsigned tg = og / nx;
            if (og + 1u == (tg + 1u) * nx) xb_add(&bar[XB_TOPGEN], 1u);
            else XB_SPIN(xb_ld(&bar[XB_TOPGEN]) == tg, bar);
            __builtin_amdgcn_fence(__ATOMIC_ACQUIRE, "agent");
            xb_add(&bar[XB_XGEN(b.x)], 1u);
            asm volatile("s_waitcnt vmcnt(0)" ::: "memory");
        } else {
            XB_SPIN(xb_ld(&bar[XB_XGEN(b.x)]) == gen, bar);
            __builtin_amdgcn_fence(__ATOMIC_ACQUIRE, "agent");
            asm volatile("s_waitcnt vmcnt(0)" ::: "memory");
        }
    }
    __syncthreads();
}
__device__ __forceinline__ Args fresh_args() {
#if defined(__HIP_DEVICE_COMPILE__)
    const CAS unsigned long long* p = (const CAS unsigned long long*)__builtin_amdgcn_kernarg_segment_ptr(); asm volatile("" : "+s"(p));
    Args a;
#pragma unroll
    for (int i = 0; i < 17; ++i) a.in[i] = (const float*)p[i];
    a.out = (float*)p[17]; a.ws = (unsigned char*)p[18];
    return a;
#else
    return Args{};
#endif
}
__global__ void __launch_bounds__(NTHREADS, 2) fwd_megakernel(Args a_unused) {
    extern __shared__ __attribute__((aligned(16))) unsigned char lds_raw[];
    LAS unsigned char* lds = (LAS unsigned char*)lds_raw;
    cg::grid_group grid = cg::this_grid();
    const int G = gridDim.x, bx = blockIdx.x, NGW = G * NWAVES;
#define FRESH() int tid = threadIdx.x; asm volatile("" : "+v"(tid)); const int lane = tid & 63, wave = __builtin_amdgcn_readfirstlane(tid >> 6), gw = bx * NWAVES + wave; (void)lane; (void)gw
#define PTRS() const Args a = fresh_args(); unsigned char* ws = a.ws; \
    float* R = (float*)(ws + WS_R); bf16_t* Wb = (bf16_t*)(ws + WS_W); bf16_t* Z = (bf16_t*)(ws + WS_Z); bf16_t* S1 = (bf16_t*)(ws + WS_S1); bf16_t* S2 = (bf16_t*)(ws + WS_S2); float* Y = a.out + O_Y; bf16_t* YA = (bf16_t*)Y; bf16_t* YB = YA + (size_t)M * DM; \
    (void)R; (void)Wb; (void)Z; (void)S1; (void)S2; (void)Y; (void)YA; (void)YB

    volatile LAS unsigned* bst = (volatile LAS unsigned*)(lds + 131072 + 64);
    { FRESH(); PTRS(); unsigned* barw = (unsigned*)(ws + WS_BAR);
      if (tid < 2) bst[tid] = 0u;
      if (bx == 0) for (int i = tid; i < XCD_BAR_WORDS; i += NTHREADS) __hip_atomic_store(barw + i, 0u, RLX_AGENT);
      for (int rep_ = 0; rep_ < 1 + ((REPMASK >> 6) & 1); ++rep_) convert_weights(a, 0, Wb, lds, gw, NGW, wave, lane);
      for (int rep_ = 0; rep_ < 1 + ((REPMASK >> 7) & 1); ++rep_) rows_prologue(a.in[0], a.in[1], S2, R, gw, NGW, lane); }
    grid.sync();
    XcdBarrier xbar;
    { PTRS(); xbar = xcd_barrier_post((unsigned*)(ws + WS_BAR), bst); }
#define GSYNC() do { XcdBarrier xb_ = xbar; asm volatile("" : "+s"(xb_.bar), "+s"(xb_.x)); xcd_barrier(xb_); } while (0)

#pragma unroll 1
    for (int l = 0; l < DEPTH; ++l) {
        for (int rep_ = 0; rep_ < 1 + ((REPMASK >> 0) & 1); ++rep_) {
            PTRS();
            pg8::Gemm g{l == 0 ? S2 : YB, Wb + W_IN, M, IN_DIM, DM}; pg8::StaticOrder S; S.init(M, IN_DIM, G, bx);
            Epi<1> E{Z, ZP, R, Z, nullptr};
            pg8::gemm_phase<Epi<1>, pg8::StaticOrder, true, true>(lds, g, S, E);
            GSYNC();
        }
        for (int rep_ = 0; rep_ < 1 + ((REPMASK >> 1) & 1); ++rep_) {
            FRESH(); PTRS();
            for (int u = bx; u < NBATCH * 16 * 2; u += G) attn_prompt_unit(a, l, u, Z, S1, lds, tid, wave, lane);
            for (int u = bx; u < DBATCH * 2; u += G) attn_sample_unit(a, l, u, Z, S1, lds, tid, wave, lane);
            conv_phase(a, l, Z, S1 + (size_t)M * ATT, bx * NTHREADS + tid, G * NTHREADS);
            GSYNC();
        }
        for (int rep_ = 0; rep_ < 1 + ((REPMASK >> 2) & 1); ++rep_) {
            PTRS();
            pg8::Gemm g{S1, Wb + W_BR, 2 * M, 2048, 512}; PairOrder S; S.init(G, bx);
            Epi<3> E{S2, DM, R, Z, nullptr};
            pg8::gemm_phase<Epi<3>, PairOrder, true, true>(lds, g, S, E);
            GSYNC();
        }
        for (int rep_ = 0; rep_ < 1 + ((REPMASK >> 3) & 1); ++rep_) {
            PTRS();
            pg8::Gemm g{S2, Wb + W_OUT, M, DM, DM}; SliceOrder S; S.init(G, bx, 32 / NSL, 16);
            Epi<4> E{S1, DM, R, Z, (float*)Z};
            pg8::gemm_phase<Epi<4>, SliceOrder, true, true>(lds, g, S, E);
            GSYNC();
        }
        { FRESH(); PTRS();
          if (l == 0) rows_residual<true, false>(S1, (const float*)Z, a.in[0], a.in[1], nullptr, a.in[6] + l * DM, nullptr, YA, R, 0, M, gw, NGW, lane);
          else        rows_residual<false, false>(S1, (const float*)Z, nullptr, nullptr, YB, a.in[6] + l * DM, nullptr, S2, R, 0, M, gw, NGW, lane); }
        GSYNC();
        for (int rep_ = 0; rep_ < 1 + ((REPMASK >> 4) & 1); ++rep_) {
            PTRS();
            pg8::Gemm g{l == 0 ? YA : S2, Wb + W_UP, M, FF, DM}; pg8::StaticOrder S; S.init(M, FF, G, bx);
            Epi<6> E{Z, FF, R, Z, nullptr};
            pg8::gemm_phase<Epi<6>, pg8::StaticOrder, true, true>(lds, g, S, E);
            GSYNC();
        }
        for (int rep_ = 0; rep_ < 1 + ((REPMASK >> 5) & 1); ++rep_) {
            PTRS();
            pg8::Gemm g{Z, Wb + W_DN, M, DM, FF}; SliceOrder S; S.init(G, bx, 64 / NSL, 64);
            Epi<4> E{S1, DM, R, Z, l == 0 ? (float*)S2 : (float*)YA};
            pg8::gemm_phase<Epi<4>, SliceOrder, true, true>(lds, g, S, E);
            GSYNC();
        }
        if (l + 1 < DEPTH) {
            { FRESH(); PTRS(); rows_residual<false, false>(S1, (const float*)S2, nullptr, nullptr, YA, a.in[8] + l * DM, nullptr, YB, R, 0, M, gw, NGW, lane);
              for (int rep_ = 0; rep_ < 1 + ((REPMASK >> 6) & 1); ++rep_) convert_weights(a, l + 1, Wb, lds, gw, NGW, wave, lane); }
            GSYNC();
        } else {
            { FRESH(); PTRS(); rows_residual<false, true>(S1, (const float*)YA, nullptr, nullptr, S2, a.in[8] + l * DM, Y, nullptr, nullptr, MP, M, gw, NGW, lane); }
            GSYNC();
            { FRESH(); PTRS(); rows_residual<false, true>(S1, nullptr, nullptr, nullptr, S2, a.in[8] + l * DM, Y, nullptr, nullptr, 0, MP, gw, NGW, lane); }
        }
    }
}

extern "C" void kernel_launch(void* const* d_in, const int* in_sizes, int n_in, void* d_out, int out_size, void* d_ws, size_t ws_size, hipStream_t stream) {
    static int grid = 0;
    if (grid == 0) {
        if (n_in != 17 || ws_size < WS_END) { fprintf(stderr, "kernel_launch: unexpected n_in %d / ws_size %zu (need %zu)\n", n_in, ws_size, (size_t)WS_END); grid = -1; return; }
        int dev = 0, cus = 0, per_cu = 0;
        hipGetDevice(&dev);
        hipDeviceGetAttribute(&cus, hipDeviceAttributeMultiprocessorCount, dev);
        if (hipFuncSetAttribute((const void*)fwd_megakernel, hipFuncAttributeMaxDynamicSharedMemorySize, LDS_BYTES) != hipSuccess) fprintf(stderr, "kernel_launch: hipFuncSetAttribute failed\n");
        if (hipOccupancyMaxActiveBlocksPerMultiprocessor(&per_cu, (const void*)fwd_megakernel, NTHREADS, LDS_BYTES) != hipSuccess || per_cu < 1) { fprintf(stderr, "kernel_launch: occupancy query gave %d\n", per_cu); per_cu = 1; }
        (void)hipGetLastError();
        grid = cus * per_cu;
    }
    if (grid < 0) return;
    Args a{};
    for (int i = 0; i < 17; ++i) a.in[i] = (const float*)d_in[i];
    a.out = (float*)d_out; a.ws = (unsigned char*)d_ws;
    void* args[] = {&a};
    hipError_t e = hipLaunchCooperativeKernel((const void*)fwd_megakernel, dim3(grid), dim3(NTHREADS), args, LDS_BYTES, stream);
    if (e != hipSuccess) fprintf(stderr, "cooperative launch failed: %s (grid %d)\n", hipGetErrorString(e), grid);
}
```

```cpp
#include <hip/hip_runtime.h>
#include <hip/hip_cooperative_groups.h>
#include <cstdio>
#include <cstdint>
namespace cg = cooperative_groups;
namespace pg8 {
#define PG8_LAS __attribute__((address_space(3)))
typedef unsigned short bf16_t;
typedef short bf16x8 __attribute__((ext_vector_type(8)));
typedef float f32x4 __attribute__((ext_vector_type(4)));
typedef unsigned u32x4 __attribute__((ext_vector_type(4)));
constexpr int BM = 256, BK = 64, HALF = 128, HTB = HALF * BK * 2  , STAGE_BYTES = 8 * HTB, NXCD = 8, WGM = 8;

__host__ __device__ __forceinline__ int lds_byte(int r, int c) { const int st = (r >> 4) * 2 + (c >> 5), rr = r & 15, cc = c & 31, ob = rr * 64 + cc * 2; return st * 1024 + (ob ^ (((ob >> 9) & 1) << 5)); }
__host__ __device__ __forceinline__ void stage_rc(int b, int& R, int& C) { const int st = b / 1024, sb = b % 1024, swz = sb ^ (((sb >> 9) & 1) << 5); R = (st >> 1) * 16 + swz / 64; C = (st & 1) * 32 + (swz % 64) / 2; }
__host__ __device__ __forceinline__ int perm32(int rho) { const int n = rho >> 4, i = rho & 15; return 8 * (i >> 2) + 4 * n + (i & 3); }

struct Unit { int pm, pn, pa, pb, w, koff, nt; };
struct Gemm { const bf16_t* A; const bf16_t* Bt; int M, N, K; };

struct StaticOrder {
    int nM, nN, nwg, G, c;
    __host__ __device__ __forceinline__ void init(int M, int N, int G_, int c_) { nM = M / BM; nN = N / BM; nwg = nM * nN; G = G_; c = c_; }
    __host__ __device__ __forceinline__ bool next(int i, Unit& u) const {
        const long L = (long)i * G + c; if (L >= nwg) return false;
        int wgid = (int)L; { const int q = nwg / NXCD, r = nwg % NXCD, xcd = wgid % NXCD, off = wgid / NXCD; wgid = (xcd < r ? xcd * (q + 1) : r * (q + 1) + (xcd - r) * q) + off; }
        const int nig = WGM * nN, gid = wgid / nig, fm = gid * WGM, gsz = (nM - fm) < WGM ? (nM - fm) : WGM;
        u.pm = fm + ((wgid % nig) % gsz); u.pn = (wgid % nig) / gsz; u.pa = u.pm; u.pb = u.pn; u.w = 0; u.koff = 0; u.nt = 0; return true;
    }
    __device__ __forceinline__ void a_ready(const Unit&) const {}
    __device__ __forceinline__ void done(const Unit&) const {}
};
__device__ __forceinline__ unsigned cvt_pk_bf16(float lo, float hi) { unsigned r; asm volatile("v_cvt_pk_bf16_f32 %0, %1, %2" : "=v"(r) : "v"(lo), "v"(hi)); return r; }
template <class Epi, class Sched, bool ALIGN_EPI = false, bool SP2 = false>
__device__ __forceinline__ void gemm_phase(PG8_LAS unsigned char* lds, const Gemm g, const Sched& S, const Epi& E) {
    int tid_ = threadIdx.x; asm volatile("" : "+v"(tid_));
    const int tid = tid_, wid = __builtin_amdgcn_readfirstlane(tid >> 6), lane = tid & 63, wr = wid >> 2, wc = wid & 3, fr = lane & 15, fq = lane >> 4;
    const int K = g.K, nt = K / BK;
    unsigned voffA[2], voffB[2];
#pragma unroll
    for (int i = 0; i < 2; ++i) { int R, C; stage_rc(tid * 16 + i * 8192, R, C); const int Rb = Epi::PERM ? ((R & ~31) + perm32(R & 31)) : R;
        voffA[i] = (unsigned)(R * K + C) * 2u; voffB[i] = (unsigned)(Rb * K + C) * 2u; }
    const size_t kstep = (size_t)(BK * 2);
    const size_t hstep = (size_t)HALF * K * 2;
    const size_t tstep = 2 * hstep;
    const unsigned ldsw = (unsigned)wid * 1024u;
    const int aoff = lds_byte(wr * 64 + fr, fq * 8), boff = lds_byte(wc * 32 + fr, fq * 8);
#define PG8_SA(b, h) (((b) * 2 + (h)) * HTB)
#define PG8_SB(b, h) ((4 + (b) * 2 + (h)) * HTB)
#define PG8_STAGE(bufoff, gbase, voff) do { _Pragma("unroll") for (int _i = 0; _i < 2; ++_i) \
        __builtin_amdgcn_global_load_lds((const unsigned*)((const char*)(gbase) + (voff)[_i]), (PG8_LAS unsigned*)(lds + (bufoff) + ldsw + _i * 8192), 16, 0, 0); } while (0)
#define PG8_LDA(dst, b, h) do { _Pragma("unroll") for (int m = 0; m < 4; ++m) _Pragma("unroll") for (int k = 0; k < 2; ++k) dst[m][k] = *(const PG8_LAS bf16x8*)(lds + PG8_SA(b, h) + aoff + m * 2048 + k * 1024); } while (0)
#define PG8_LDB(dst, b, h) do { _Pragma("unroll") for (int n = 0; n < 2; ++n) _Pragma("unroll") for (int k = 0; k < 2; ++k) dst[n][k] = *(const PG8_LAS bf16x8*)(lds + PG8_SB(b, h) + boff + n * 2048 + k * 1024); } while (0)
#define PG8_MMA(ai, bj, At, Bt) do { __builtin_amdgcn_s_setprio(1); _Pragma("unroll") for (int m = 0; m < 4; ++m) _Pragma("unroll") for (int n = 0; n < 2; ++n) _Pragma("unroll") for (int k = 0; k < 2; ++k) \
        acc[ai][bj][m][n] = __builtin_amdgcn_mfma_f32_16x16x32_bf16(Bt[n][k], At[m][k], acc[ai][bj][m][n], 0, 0, 0); __builtin_amdgcn_s_setprio(0); } while (0)
#define PG8_WAIT_V(n) asm volatile("s_waitcnt vmcnt(" #n ")" ::: "memory")
#define PG8_WAIT_L(n) asm volatile("s_waitcnt lgkmcnt(" #n ")" ::: "memory")
#define PG8_BAR __builtin_amdgcn_s_barrier()
#define PG8_SCHED __builtin_amdgcn_sched_barrier(0)
    Unit cur, nxt; int ui = 0;
    if (!S.next(0, cur)) return;
    f32x4 acc[2][2][4][2];
#pragma unroll
    for (int a = 0; a < 2; ++a)
#pragma unroll
        for (int b = 0; b < 2; ++b)
#pragma unroll
            for (int m = 0; m < 4; ++m)
#pragma unroll
                for (int n = 0; n < 2; ++n) acc[a][b][m][n] = (f32x4){0.f, 0.f, 0.f, 0.f};
    bf16x8 At[4][2], B0[2][2], B1[2][2];
    const char* cA = (const char*)g.A + (size_t)cur.pa * tstep + cur.koff; const char* cB = (const char*)g.Bt + (size_t)cur.pb * tstep + cur.koff;
    S.a_ready(cur);
    if constexpr (SP2) {
        PG8_STAGE(PG8_SB(0, 0), cB, voffB); PG8_STAGE(PG8_SB(0, 1), cB + hstep, voffB); PG8_STAGE(PG8_SA(0, 0), cA, voffA); PG8_STAGE(PG8_SA(0, 1), cA + hstep, voffA);
        if (wr == 1) PG8_BAR;
        PG8_WAIT_V(2); PG8_BAR;
        PG8_STAGE(PG8_SB(1, 0), cB + kstep, voffB); PG8_STAGE(PG8_SA(1, 0), cA + kstep, voffA); PG8_STAGE(PG8_SB(1, 1), cB + hstep + kstep, voffB);
        PG8_WAIT_V(6); PG8_BAR;
    } else {
        PG8_STAGE(PG8_SB(0, 0), cB, voffB); PG8_STAGE(PG8_SA(0, 0), cA, voffA); PG8_STAGE(PG8_SB(0, 1), cB + hstep, voffB); PG8_STAGE(PG8_SA(0, 1), cA + hstep, voffA);
        if (wr == 1) PG8_BAR;
        PG8_WAIT_V(4); PG8_BAR;
        PG8_STAGE(PG8_SB(1, 0), cB + kstep, voffB); PG8_STAGE(PG8_SA(1, 0), cA + kstep, voffA); PG8_STAGE(PG8_SB(1, 1), cB + hstep + kstep, voffB);
        PG8_WAIT_V(6); PG8_BAR;
    }
    for (;;) {
        const bool has_next = S.next(ui + 1, nxt);
        const char* nA = has_next ? (const char*)g.A + (size_t)nxt.pa * tstep + nxt.koff : cA; const char* nB = has_next ? (const char*)g.Bt + (size_t)nxt.pb * tstep + nxt.koff : cB;
        const int unt = cur.nt ? cur.nt : nt;
        for (int t = 0; t < unt; t += 2) {
            const bool last = (t == unt - 2);
            const char* a1 = cA + (size_t)(t + 1) * kstep;
            const char* a2 = last ? nA : cA + (size_t)(t + 2) * kstep; const char* b2 = last ? nB : cB + (size_t)(t + 2) * kstep;
            const char* a3 = a2 + kstep; const char* b3 = b2 + kstep;
            if (last && has_next) S.a_ready(nxt);
            if constexpr (SP2) {
            PG8_LDB(B0, 0, 0); PG8_LDB(B1, 0, 1); PG8_SCHED; PG8_LDA(At, 0, 0); PG8_STAGE(PG8_SA(1, 1), a1 + hstep, voffA);
            PG8_WAIT_V(8); PG8_WAIT_L(0); PG8_BAR; PG8_MMA(0, 0, At, B0); PG8_MMA(0, 1, At, B1); PG8_BAR; PG8_SCHED;
            PG8_LDA(At, 0, 1); PG8_STAGE(PG8_SB(0, 0), b2, voffB); PG8_STAGE(PG8_SB(0, 1), b2 + hstep, voffB); PG8_STAGE(PG8_SA(0, 0), a2, voffA);
            PG8_WAIT_V(8); PG8_WAIT_L(0); PG8_BAR; PG8_MMA(1, 0, At, B0); PG8_MMA(1, 1, At, B1); PG8_BAR; PG8_SCHED;
            PG8_LDB(B0, 1, 0); PG8_LDB(B1, 1, 1); PG8_SCHED; PG8_LDA(At, 1, 0); PG8_STAGE(PG8_SA(0, 1), a2 + hstep, voffA);
            PG8_WAIT_V(8); PG8_WAIT_L(0); PG8_BAR; PG8_MMA(0, 0, At, B0); PG8_MMA(0, 1, At, B1); PG8_BAR; PG8_SCHED;
            PG8_LDA(At, 1, 1); PG8_STAGE(PG8_SB(1, 0), b3, voffB); PG8_STAGE(PG8_SB(1, 1), b3 + hstep, voffB); PG8_STAGE(PG8_SA(1, 0), a3, voffA);
            PG8_WAIT_V(8); PG8_WAIT_L(0); PG8_BAR; PG8_MMA(1, 0, At, B0); PG8_MMA(1, 1, At, B1); PG8_BAR; PG8_SCHED;
            } else {
            PG8_LDB(B0, 0, 0); PG8_SCHED; PG8_LDA(At, 0, 0); PG8_STAGE(PG8_SA(1, 1), a1 + hstep, voffA);
            PG8_WAIT_L(8); PG8_BAR; PG8_WAIT_L(0); PG8_MMA(0, 0, At, B0); PG8_BAR; PG8_SCHED;
            PG8_LDB(B1, 0, 1); PG8_STAGE(PG8_SB(0, 0), b2, voffB);
            PG8_BAR; PG8_WAIT_L(0); PG8_MMA(0, 1, At, B1); PG8_BAR;
            PG8_LDA(At, 0, 1); PG8_STAGE(PG8_SA(0, 0), a2, voffA);
            PG8_BAR; PG8_WAIT_L(0); PG8_MMA(1, 0, At, B0); PG8_BAR; PG8_SCHED;
            PG8_STAGE(PG8_SB(0, 1), b2 + hstep, voffB);
            PG8_WAIT_V(6); PG8_BAR; PG8_MMA(1, 1, At, B1); PG8_BAR;
            PG8_LDB(B0, 1, 0); PG8_SCHED; PG8_LDA(At, 1, 0); PG8_STAGE(PG8_SA(0, 1), a2 + hstep, voffA);
            PG8_WAIT_L(8); PG8_BAR; PG8_WAIT_L(0); PG8_MMA(0, 0, At, B0); PG8_BAR; PG8_SCHED;
            PG8_LDB(B1, 1, 1); PG8_STAGE(PG8_SB(1, 0), b3, voffB);
            PG8_BAR; PG8_WAIT_L(0); PG8_MMA(0, 1, At, B1); PG8_BAR;
            PG8_LDA(At, 1, 1); PG8_STAGE(PG8_SA(1, 0), a3, voffA);
            PG8_BAR; PG8_WAIT_L(0); PG8_MMA(1, 0, At, B0); PG8_BAR; PG8_SCHED;
            PG8_STAGE(PG8_SB(1, 1), b3 + hstep, voffB);
            PG8_WAIT_V(6); PG8_BAR; PG8_MMA(1, 1, At, B1); PG8_BAR;
            }
        }
        if constexpr (ALIGN_EPI) { if (wr == 0) PG8_BAR; }
        if constexpr (!Epi::AFTER_DRAIN) { E(acc, cur, wr, wc, fr, fq); S.done(cur); }
        if (!has_next) break;
#pragma unroll
        for (int a = 0; a < 2; ++a)
#pragma unroll
            for (int b = 0; b < 2; ++b)
#pragma unroll
                for (int m = 0; m < 4; ++m)
#pragma unroll
                    for (int n = 0; n < 2; ++n) acc[a][b][m][n] = (f32x4){0.f, 0.f, 0.f, 0.f};
        cur = nxt; cA = nA; cB = nB; ++ui;
        if constexpr (ALIGN_EPI) { if (wr == 1) PG8_BAR; }
    }
    PG8_WAIT_V(0);
    if constexpr (!ALIGN_EPI) { if (wr == 0) PG8_BAR; }
    PG8_BAR;
    if constexpr (Epi::AFTER_DRAIN) { E.fused(acc, cur, wr, wc, fr, fq, lds, wid, lane); S.done(cur); }
#undef PG8_SA
#undef PG8_SB
#undef PG8_STAGE
#undef PG8_LDA
#undef PG8_LDB
#undef PG8_MMA
#undef PG8_WAIT_V
#undef PG8_WAIT_L
#undef PG8_BAR
#undef PG8_SCHED
}
}
#ifndef REPMASK
#define REPMASK 0
#endif
#define LAS __attribute__((address_space(3)))
#define CAS __attribute__((address_space(4)))
typedef unsigned short bf16_t;
typedef short bf16x8 __attribute__((ext_vector_type(8)));
typedef float f32x4 __attribute__((ext_vector_type(4)));
typedef unsigned u32x4 __attribute__((ext_vector_type(4)));
typedef unsigned u32x2 __attribute__((ext_vector_type(2)));

constexpr int DM = 1024, NBATCH = 8, SEQ = 2048, DEPTH = 2, DBATCH = 128, DSEQ = 8;
constexpr int MP = NBATCH * SEQ, MS = DBATCH * DSEQ, M = MP + MS;
constexpr int IN_DIM = 4352, ATT = 512, CD = 512, FF = 4096;
constexpr int ZP = IN_DIM;
constexpr int ZQ = 0, ZK = 512, ZV = 640, ZB = 768, ZC = 1280, ZU = 1792, ZGA = 2304;
constexpr float EPS = 1e-6f;
constexpr float LOG2E = 1.4426950408889634f;

constexpr size_t O_Y = 0;
constexpr size_t O_KP = (size_t)M * DM;
constexpr size_t O_VP = O_KP + 2 * 8 * 128 * 128;
constexpr size_t O_CP = O_VP + 2 * 8 * 128 * 128;
constexpr size_t O_KS = O_CP + 2 * 8 * 2 * 512;
constexpr size_t O_VS = O_KS + (size_t)2 * 128 * 128 * 128;
constexpr size_t O_CS = O_VS + (size_t)2 * 128 * 128 * 128;

constexpr size_t MiB = 1u << 20;
constexpr size_t WS_R = 0;
constexpr size_t WS_BAR = 512 * 1024;
constexpr size_t WS_W = 3 * MiB;
constexpr size_t W_IN = 0, W_BR = W_IN + (size_t)IN_DIM * DM, W_OUT = W_BR + (size_t)2048 * 512, W_UP = W_OUT + (size_t)DM * DM, W_DN = W_UP + (size_t)FF * DM, W_END = W_DN + (size_t)DM * FF;
constexpr size_t WS_Z = 32 * MiB;
constexpr size_t WS_S1 = 177 * MiB;
constexpr size_t WS_S2 = 211 * MiB;
constexpr size_t WS_END = 247 * MiB;
constexpr int NSL = 8;
static_assert(WS_W + W_END * 2 <= WS_Z && WS_Z + (size_t)M * ZP * 2 <= WS_S1 && WS_S1 + (size_t)M * DM * 2 <= WS_S2 && WS_S2 + (size_t)(M + 1024) * DM * 2 <= WS_END, "ws map");

constexpr int LDS_BYTES = 147456;
constexpr int NTHREADS = 512, NWAVES = 8;

__device__ __forceinline__ float bf2f(unsigned b) { return __uint_as_float(b << 16); }
typedef float f32x2_t __attribute__((ext_vector_type(2))); typedef __bf16 bf16x2_t __attribute__((ext_vector_type(2)));
__device__ __forceinline__ unsigned pk2(float lo, float hi) { const f32x2_t v = {lo, hi}; const bf16x2_t b = __builtin_convertvector(v, bf16x2_t); return __builtin_bit_cast(unsigned, b); }
__device__ __forceinline__ float wave_sum(float v) {
#pragma unroll
    for (int o = 1; o < 64; o <<= 1) v += __shfl_xor(v, o);
    return v;
}
__device__ __forceinline__ void unpack8(const u32x4 v, float (&f)[8]) {
    f[0] = bf2f(v.x & 0xffffu); f[1] = __uint_as_float(v.x & 0xffff0000u); f[2] = bf2f(v.y & 0xffffu); f[3] = __uint_as_float(v.y & 0xffff0000u);
    f[4] = bf2f(v.z & 0xffffu); f[5] = __uint_as_float(v.z & 0xffff0000u); f[6] = bf2f(v.w & 0xffffu); f[7] = __uint_as_float(v.w & 0xffff0000u);
}
__device__ __forceinline__ u32x4 pack8(const float (&f)[8]) { u32x4 w; w.x = pk2(f[0], f[1]); w.y = pk2(f[2], f[3]); w.z = pk2(f[4], f[5]); w.w = pk2(f[6], f[7]); return w; }
__device__ __forceinline__ float sigmoidf_fast(float x) { return __builtin_amdgcn_rcpf(1.0f + __builtin_amdgcn_exp2f(-x * LOG2E)); }

template <int MODE> struct Epi {
    static constexpr bool PERM = true, AFTER_DRAIN = false;
    bf16_t* O; int ldc; const float* r; const bf16_t* Z; float* part;
    __device__ __forceinline__ void operator()(const f32x4 (&acc)[2][2][4][2], const pg8::Unit& u, int wr, int wc, int fr, int fq) const {
        const int row0 = u.pm * 256 + wr * 64 + fr, col0 = u.pn * 256 + wc * 32 + 8 * fq;
        const bool smp = u.pm >= MP / 256;
        float rs[2][4];
        if (MODE == 1 || MODE == 6) {
#pragma unroll
            for (int ai = 0; ai < 2; ++ai)
#pragma unroll
                for (int m = 0; m < 4; ++m) rs[ai][m] = r[row0 + ai * 128 + m * 16];
        }
#pragma unroll
        for (int ai = 0; ai < 2; ++ai) {
            u32x4 gt[4][2], tv[4][2];
            if (MODE == 3) {
#pragma unroll
                for (int m = 0; m < 4; ++m)
#pragma unroll
                    for (int bj = 0; bj < 2; ++bj) gt[m][bj] = *(const u32x4*)(Z + (size_t)(row0 + ai * 128 + m * 16) * ZP + ZGA + u.w * 1024 + col0 + bj * 128);
                if (u.w == 1 && !smp) {
#pragma unroll
                    for (int m = 0; m < 4; ++m)
#pragma unroll
                        for (int bj = 0; bj < 2; ++bj) tv[m][bj] = *(const u32x4*)(O + (size_t)(row0 + ai * 128 + m * 16) * ldc + col0 + bj * 128);
                }
            }
#pragma unroll
            for (int m = 0; m < 4; ++m) {
                const int row = row0 + ai * 128 + m * 16;
#pragma unroll
                for (int bj = 0; bj < 2; ++bj) {
                    const int col = col0 + bj * 128;
                    const f32x4 a0 = acc[ai][bj][m][0], a1 = acc[ai][bj][m][1];
                    if (MODE == 4 && smp) {
                        float* pd = part + ((size_t)u.w * MS + (row - MP)) * DM + col;
                        *(f32x4*)pd = a0; *(f32x4*)(pd + 4) = a1; continue; }
                    bf16_t* dst = O + (size_t)(row + ((MODE == 3 && smp) ? u.w * MS : 0)) * ldc + col;
                    float v[8] = {a0[0], a0[1], a0[2], a0[3], a1[0], a1[1], a1[2], a1[3]};
                    if (MODE == 1) {
#pragma unroll
                        for (int e = 0; e < 8; ++e) v[e] *= rs[ai][m];
                        if (u.pn >= 9) {
#pragma unroll
                            for (int e = 0; e < 8; ++e) v[e] = sigmoidf_fast(v[e]);
                        }
                    } else if (MODE == 3) {
                        float g8[8]; unpack8(gt[m][bj], g8);
#pragma unroll
                        for (int e = 0; e < 8; ++e) v[e] *= g8[e];
                        if (u.w == 1 && !smp) { float t[8]; unpack8(tv[m][bj], t);
#pragma unroll
                            for (int e = 0; e < 8; ++e) v[e] += t[e]; }
                    } else if (MODE == 6) {
#pragma unroll
                        for (int e = 0; e < 8; ++e) { const float q = fmaxf(v[e] * rs[ai][m], 0.f); v[e] = q * q; }
                    }
                    *(u32x4*)dst = pack8(v);
                }
            }
        }
    }
};

struct PairOrder {
    pg8::StaticOrder so; int c;
    __device__ __forceinline__ void init(int G_, int c_) { so.init(MP, DM, G_, c_); c = c_; }
    __device__ __forceinline__ bool next(int i, pg8::Unit& u) const {
        const int np = (so.nwg - c + so.G - 1) / so.G;
        pg8::Unit t; t.pm = 0; t.pn = 0; t.pa = 0; t.pb = 0; t.w = 0; t.koff = 0; t.nt = 0;
        bool ok;
        if (i < 2 * np) { ok = so.next(i >> 1, t); t.w = i & 1; }
        else { const int j = (i - 2 * np) * so.G + c; ok = j < 32; t.pm = MP / 256 + ((j >> 3) & 3); t.pn = (j >> 1) & 3; t.w = j & 1; }
        t.koff = 0; t.nt = 0; t.pa = t.w * (M / 256) + t.pm; t.pb = t.w * 4 + t.pn; u = t; return ok; }
    __device__ __forceinline__ void a_ready(const pg8::Unit&) const {}
    __device__ __forceinline__ void done(const pg8::Unit&) const {}
};
struct SliceOrder {
    pg8::StaticOrder so; int c, ntl, wrapk;
    __device__ __forceinline__ void init(int G_, int c_, int ntl_, int wrapk_) { so.init(MP, DM, G_, c_); c = c_; ntl = ntl_; wrapk = wrapk_; }
    __device__ __forceinline__ bool next(int i, pg8::Unit& u) const {
        const int nsl = (c < 16 * NSL) ? (16 * NSL - c + so.G - 1) / so.G : 0;
        pg8::Unit t; t.pm = 0; t.pn = 0; t.pa = 0; t.pb = 0; t.w = 0; t.koff = 0; t.nt = 0;
        bool ok;
        if (i < nsl) { const int j = i * so.G + c, tile = j / NSL, s = j % NSL, kt0 = s * ntl, src = kt0 / wrapk; ok = true;
            t.pm = MP / 256 + (tile >> 2); t.pn = tile & 3; t.w = s; t.pa = MP / 256 + src * 4 + (tile >> 2); t.pb = t.pn; t.koff = (kt0 % wrapk) * 128; t.nt = ntl; }
        else ok = so.next(i - nsl, t);
        u = t; return ok; }
    __device__ __forceinline__ void a_ready(const pg8::Unit&) const {}
    __device__ __forceinline__ void done(const pg8::Unit&) const {}
};

__device__ __forceinline__ void transpose_item(const float* W, const float* gk, int K, int N, bf16_t* WT, int row_off, LAS float* scr, int item, int lane) {
    const int nblk = N / 32, kb = item / nblk, nb = item % nblk, k0 = 64 * kb, n0 = 32 * nb;
    float wv[32];
#pragma unroll
    for (int i = 0; i < 32; ++i) { const int kk = 2 * i + (lane >> 5); wv[i] = W[(size_t)(k0 + kk) * N + n0 + (lane & 31)]; }
    if (gk) {
#pragma unroll
        for (int i = 0; i < 32; ++i) wv[i] *= gk[k0 + 2 * i + (lane >> 5)];
    }
#pragma unroll
    for (int i = 0; i < 32; ++i) { const int kk = 2 * i + (lane >> 5); scr[kk * 33 + (lane & 31)] = wv[i]; }
    asm volatile("s_waitcnt lgkmcnt(0)" ::: "memory");
    const int c = lane & 7;
#pragma unroll
    for (int j = 0; j < 4; ++j) { const int n = (lane >> 3) + 8 * j; const LAS float* s = scr + (8 * c) * 33 + n;
        u32x4 o; o.x = pk2(s[0 * 33], s[1 * 33]); o.y = pk2(s[2 * 33], s[3 * 33]); o.z = pk2(s[4 * 33], s[5 * 33]); o.w = pk2(s[6 * 33], s[7 * 33]);
        *(u32x4*)(WT + (size_t)(row_off + n0 + n) * K + k0 + 8 * c) = o; }
    asm volatile("s_waitcnt lgkmcnt(0)" ::: "memory");
}
struct Args { const float* in[17]; float* out; unsigned char* ws; };

__device__ __forceinline__ void convert_weights(const Args& a, int l, bf16_t* Wb, LAS unsigned char* lds, int gw, int NGW, int wave, int lane) {
    LAS float* scr = (LAS float*)(lds + wave * 16384);
    constexpr int I_IN = 16 * 136, I_AO = 8 * 32, I_CO = 8 * 32, I_OUT = 16 * 32, I_UP = 16 * 128, I_DN = 64 * 32;
    constexpr int NITEMS = I_IN + I_AO + I_CO + I_OUT + I_UP + I_DN;
    const float* w_in = a.in[9] + (size_t)l * DM * IN_DIM; const float* w_ao = a.in[12] + (size_t)l * ATT * DM; const float* w_co = a.in[13] + (size_t)l * CD * DM;
    const float* w_out = a.in[14] + (size_t)l * DM * DM; const float* w_up = a.in[15] + (size_t)l * DM * FF; const float* w_dn = a.in[16] + (size_t)l * FF * DM;
    const float* g_pre = a.in[5] + l * DM; const float* g_mlp = a.in[7] + l * DM;
    for (int it = gw; it < NITEMS; it += NGW) {
        int r = it;
        if (r < I_IN) { transpose_item(w_in, g_pre, DM, IN_DIM, Wb + W_IN, 0, scr, r, lane); continue; } r -= I_IN;
        if (r < I_AO) { transpose_item(w_ao, nullptr, ATT, DM, Wb + W_BR, 0, scr, r, lane); continue; } r -= I_AO;
        if (r < I_CO) { transpose_item(w_co, nullptr, CD, DM, Wb + W_BR, 1024, scr, r, lane); continue; } r -= I_CO;
        if (r < I_OUT) { transpose_item(w_out, nullptr, DM, DM, Wb + W_OUT, 0, scr, r, lane); continue; } r -= I_OUT;
        if (r < I_UP) { transpose_item(w_up, g_mlp, DM, FF, Wb + W_UP, 0, scr, r, lane); continue; } r -= I_UP;
        transpose_item(w_dn, nullptr, FF, DM, Wb + W_DN, 0, scr, r, lane);
    }
}

__device__ __forceinline__ void rows_prologue(const float* xp, const float* xs, bf16_t* xb, float* r, int gw, int NGW, int lane) {
    for (int row0 = gw; row0 < M; row0 += 4 * NGW) {
        f32x4 v[4][4];
#pragma unroll
        for (int b = 0; b < 4; ++b) { const int row = row0 + b * NGW;
            if (row < M) { const float* xr = (row < MP) ? xp + (size_t)row * DM : xs + (size_t)(row - MP) * DM;
#pragma unroll
                for (int j = 0; j < 4; ++j) v[b][j] = *(const f32x4*)(xr + 4 * lane + 256 * j); } }
#pragma unroll
        for (int b = 0; b < 4; ++b) { const int row = row0 + b * NGW;
            if (row < M) { float ss = 0.f;
#pragma unroll
                for (int j = 0; j < 4; ++j) ss += (v[b][j][0] * v[b][j][0] + v[b][j][1] * v[b][j][1]) + (v[b][j][2] * v[b][j][2] + v[b][j][3] * v[b][j][3]);
                ss = wave_sum(ss);
#pragma unroll
                for (int j = 0; j < 4; ++j) { u32x2 w; w.x = pk2(v[b][j][0], v[b][j][1]); w.y = pk2(v[b][j][2], v[b][j][3]); *(u32x2*)(xb + (size_t)row * DM + 4 * lane + 256 * j) = w; }
                if (lane == 0) r[row] = 1.0f / sqrtf(ss * (1.0f / DM) + EPS); } }
    }
}
constexpr int RB = 4;
template <bool XF32, bool WY>
__device__ __forceinline__ void rows_residual(const bf16_t* src, const float* part, const float* xin_p, const float* xin_s, const bf16_t* xin_b, const float* g, float* yout, bf16_t* xb, float* r, int rb, int re, int gw, int NGW, int lane) {
    f32x4 gv[4];
#pragma unroll
    for (int j = 0; j < 4; ++j) gv[j] = *(const f32x4*)(g + 4 * lane + 256 * j);
    for (int row0 = rb + gw; row0 < re; row0 += RB * NGW) {
        f32x4 s[RB][4], x[RB][4];
#pragma unroll
        for (int b = 0; b < RB; ++b) {
            const int row = row0 + b * NGW;
            if (row < re) {
#pragma unroll
                for (int j = 0; j < 4; ++j) {
                    if (XF32) { const float* xr = (row < MP) ? xin_p + (size_t)row * DM : xin_s + (size_t)(row - MP) * DM; x[b][j] = *(const f32x4*)(xr + 4 * lane + 256 * j); }
                    else { const u32x2 w = *(const u32x2*)(xin_b + (size_t)row * DM + 4 * lane + 256 * j);
                        x[b][j][0] = bf2f(w.x & 0xffffu); x[b][j][1] = __uint_as_float(w.x & 0xffff0000u); x[b][j][2] = bf2f(w.y & 0xffffu); x[b][j][3] = __uint_as_float(w.y & 0xffff0000u); }
                    if (row < MP) { const u32x2 w = *(const u32x2*)(src + (size_t)row * DM + 4 * lane + 256 * j);
                        s[b][j][0] = bf2f(w.x & 0xffffu); s[b][j][1] = __uint_as_float(w.x & 0xffff0000u); s[b][j][2] = bf2f(w.y & 0xffffu); s[b][j][3] = __uint_as_float(w.y & 0xffff0000u); }
                    else { const float* pp = part + (size_t)(row - MP) * DM + 4 * lane + 256 * j; s[b][j] = *(const f32x4*)pp;
#pragma unroll
                        for (int q = 1; q < NSL; ++q) s[b][j] += *(const f32x4*)(pp + (size_t)q * MS * DM); } }
            }
        }
#pragma unroll
        for (int b = 0; b < RB; ++b) {
            const int row = row0 + b * NGW;
            if (row < re) {
                float ss = 0.f;
#pragma unroll
                for (int j = 0; j < 4; ++j) ss += (s[b][j][0] * s[b][j][0] + s[b][j][1] * s[b][j][1]) + (s[b][j][2] * s[b][j][2] + s[b][j][3] * s[b][j][3]);
                ss = wave_sum(ss);
                const float rm = 1.0f / sqrtf(ss * (1.0f / DM) + EPS);
#pragma unroll
                for (int j = 0; j < 4; ++j) x[b][j] = x[b][j] + s[b][j] * rm * gv[j];
                if (WY) {
#pragma unroll
                    for (int j = 0; j < 4; ++j) *(f32x4*)(yout + (size_t)row * DM + 4 * lane + 256 * j) = x[b][j];
                } else {
                    float s2 = 0.f;
#pragma unroll
                    for (int j = 0; j < 4; ++j) { u32x2 w; w.x = pk2(x[b][j][0], x[b][j][1]); w.y = pk2(x[b][j][2], x[b][j][3]); *(u32x2*)(xb + (size_t)row * DM + 4 * lane + 256 * j) = w;
                        const float q0 = bf2f(w.x & 0xffffu), q1 = __uint_as_float(w.x & 0xffff0000u), q2 = bf2f(w.y & 0xffffu), q3 = __uint_as_float(w.y & 0xffff0000u);
                        s2 += (q0 * q0 + q1 * q1) + (q2 * q2 + q3 * q3); }
                    s2 = wave_sum(s2);
                    if (lane == 0) r[row] = 1.0f / sqrtf(s2 * (1.0f / DM) + EPS);
                }
            }
        }
    }
}

constexpr int KS_STRIDE = 72, VT_STRIDE = 264;
constexpr int VT_OFF = 256 * KS_STRIDE * 2;
constexpr float SC_L2 = 0.125f * LOG2E;

template <bool SAMPLE>
__device__ __forceinline__ void attn_qtile(const LAS unsigned char* lds, const bf16x8 qf0, const bf16x8 qf1, bf16_t* AO, int qrow, int head, int iq, int tb, bool has_prev, float sink_l2, int lane) {
    const int q = lane & 15, g = lane >> 4;
    f32x4 s[10];
    const LAS unsigned char* kbase = lds + ((tb * 16 + q) * KS_STRIDE + 8 * g) * 2;
    const int lo1 = (!SAMPLE && !has_prev && iq < 127) ? 128 : iq + 1;
    const unsigned span = (unsigned)(iq + 128 - lo1);
    const int d0 = tb * 16 + 4 * g - lo1;
    float mx = sink_l2;
#pragma unroll
    for (int t = 0; t < 10; ++t) {
        const bf16x8 a0 = *(const LAS bf16x8*)(kbase + t * 16 * KS_STRIDE * 2);
        const bf16x8 a1 = *(const LAS bf16x8*)(kbase + t * 16 * KS_STRIDE * 2 + 64);
        f32x4 z = {0.f, 0.f, 0.f, 0.f};
        z = __builtin_amdgcn_mfma_f32_16x16x32_bf16(a0, qf0, z, 0, 0, 0);
        z = __builtin_amdgcn_mfma_f32_16x16x32_bf16(a1, qf1, z, 0, 0, 0);
#pragma unroll
        for (int j = 0; j < 4; ++j) {
            const bool vis = (unsigned)(d0 + t * 16 + j) <= span;
            const float v = vis ? z[j] * SC_L2 : -INFINITY;
            z[j] = v; mx = fmaxf(mx, v);
        }
        s[t] = z;
    }
    mx = fmaxf(mx, __shfl_xor(mx, 16)); mx = fmaxf(mx, __shfl_xor(mx, 32));
    float sum = 0.f;
#pragma unroll
    for (int t = 0; t < 10; ++t)
#pragma unroll
        for (int j = 0; j < 4; ++j) { const float p = __builtin_amdgcn_exp2f(s[t][j] - mx); s[t][j] = p; sum += p; }
    sum += __shfl_xor(sum, 16); sum += __shfl_xor(sum, 32);
    sum += __builtin_amdgcn_exp2f(sink_l2 - mx);
    const float inv = 1.0f / sum;
    bf16x8 pf[5];
#pragma unroll
    for (int c = 0; c < 5; ++c) {
        u32x4 w; w.x = pk2(s[2 * c][0] * inv, s[2 * c][1] * inv); w.y = pk2(s[2 * c][2] * inv, s[2 * c][3] * inv);
        w.z = pk2(s[2 * c + 1][0] * inv, s[2 * c + 1][1] * inv); w.w = pk2(s[2 * c + 1][2] * inv, s[2 * c + 1][3] * inv);
        pf[c] = __builtin_bit_cast(bf16x8, w);
    }
    f32x4 o[4];
#pragma unroll
    for (int dt = 0; dt < 4; ++dt) o[dt] = (f32x4){0.f, 0.f, 0.f, 0.f};
    const LAS unsigned char* vbase = lds + VT_OFF + (q * VT_STRIDE + tb * 16 + 4 * g) * 2;
#pragma unroll
    for (int c = 0; c < 5; ++c)
#pragma unroll
        for (int dt = 0; dt < 4; ++dt) {
            const u32x2 lo = *(const LAS u32x2*)(vbase + dt * 16 * VT_STRIDE * 2 + c * 64);
            const u32x2 hi = *(const LAS u32x2*)(vbase + dt * 16 * VT_STRIDE * 2 + c * 64 + 32);
            const u32x4 av = {lo.x, lo.y, hi.x, hi.y};
            o[dt] = __builtin_amdgcn_mfma_f32_16x16x32_bf16(__builtin_bit_cast(bf16x8, av), pf[c], o[dt], 0, 0, 0);
        }
#pragma unroll
    for (int dt = 0; dt < 4; ++dt) { u32x2 w; w.x = pk2(o[dt][0], o[dt][1]); w.y = pk2(o[dt][2], o[dt][3]);
        *(u32x2*)(AO + (size_t)qrow * ATT + head * 64 + dt * 16 + 4 * g) = w; }
}

__device__ __forceinline__ void lds_put_kv(LAS unsigned char* lds, int key, int ch, u32x4 kv, u32x4 vv) {
    *(LAS u32x4*)(lds + key * (KS_STRIDE * 2) + ch * 16) = kv;
    LAS unsigned short* vt = (LAS unsigned short*)(lds + VT_OFF) + (ch * 8) * VT_STRIDE + key;
    vt[0 * VT_STRIDE] = (unsigned short)(vv.x & 0xffffu); vt[1 * VT_STRIDE] = (unsigned short)(vv.x >> 16);
    vt[2 * VT_STRIDE] = (unsigned short)(vv.y & 0xffffu); vt[3 * VT_STRIDE] = (unsigned short)(vv.y >> 16);
    vt[4 * VT_STRIDE] = (unsigned short)(vv.z & 0xffffu); vt[5 * VT_STRIDE] = (unsigned short)(vv.z >> 16);
    vt[6 * VT_STRIDE] = (unsigned short)(vv.w & 0xffffu); vt[7 * VT_STRIDE] = (unsigned short)(vv.w >> 16);
}
__device__ __forceinline__ void store8f(float* dst, const u32x4 v) { float f[8]; unpack8(v, f); *(f32x4*)dst = (f32x4){f[0], f[1], f[2], f[3]}; *(f32x4*)(dst + 4) = (f32x4){f[4], f[5], f[6], f[7]}; }

__device__ __forceinline__ void attn_prompt_unit(const Args& a, int l, int unit, const bf16_t* Z, bf16_t* AO, LAS unsigned char* lds, int tid, int wave, int lane) {
    const int b = unit >> 5, qb = (unit >> 1) & 15, kvh = unit & 1;
    const int rowbase = b * SEQ + qb * 128;
    const bool has_prev = qb > 0;
    const int hh = wave >> 1, half = wave & 1, head = kvh * 4 + hh;
    bf16x8 qf[4][2];
#pragma unroll
    for (int qt = 0; qt < 4; ++qt) { const bf16_t* qp = Z + (size_t)(rowbase + half * 64 + qt * 16 + (lane & 15)) * ZP + ZQ + head * 64 + 8 * (lane >> 4);
        qf[qt][0] = *(const bf16x8*)qp; qf[qt][1] = *(const bf16x8*)(qp + 32); }
#pragma unroll
    for (int i = 0; i < 4; ++i) {
        const int item = tid + NTHREADS * i, key = item >> 3, ch = item & 7;
        u32x4 kv = {0u, 0u, 0u, 0u}, vv = {0u, 0u, 0u, 0u};
        if (has_prev || key >= 128) {
            const bf16_t* zr = Z + (size_t)(rowbase - 128 + key) * ZP + kvh * 64 + ch * 8;
            kv = *(const u32x4*)(zr + ZK); vv = *(const u32x4*)(zr + ZV);
            if (qb == 15 && key >= 128) {
                const size_t o = (((size_t)(l * NBATCH + b) * 128 + (key - 128)) * 2 + kvh) * 64 + ch * 8;
                store8f(a.out + O_KP + o, kv); store8f(a.out + O_VP + o, vv);
            }
        }
        lds_put_kv(lds, key, ch, kv, vv);
    }
    __syncthreads();
    const float sink_l2 = a.in[10][l * 8 + head] * LOG2E;
#pragma unroll
    for (int qt = 0; qt < 4; ++qt) {
        const int iq0 = half * 64 + qt * 16, iq = iq0 + (lane & 15);
        attn_qtile<false>(lds, qf[qt][0], qf[qt][1], AO, rowbase + iq, head, iq, (iq0 >> 4) & ~1, has_prev, sink_l2, lane);
    }
    __syncthreads();
}
__device__ __forceinline__ void attn_sample_unit(const Args& a, int l, int unit, const bf16_t* Z, bf16_t* AO, LAS unsigned char* lds, int tid, int wave, int lane) {
    const int n = unit >> 1, kvh = unit & 1;
    const float* ck = a.in[2] + ((size_t)(l * DBATCH + n) * 128) * 128 + kvh * 64;
    const float* cv = a.in[3] + ((size_t)(l * DBATCH + n) * 128) * 128 + kvh * 64;
    const int sq = lane & 15, shead = kvh * 4 + (wave & 1) * 2 + (sq >> 3), st = sq & 7;
    const bf16_t* sqp = Z + (size_t)(MP + n * DSEQ + st) * ZP + ZQ + shead * 64 + 8 * (lane >> 4);
    const bf16x8 sqf0 = *(const bf16x8*)sqp, sqf1 = *(const bf16x8*)(sqp + 32);
#pragma unroll
    for (int i = 0; i < 3; ++i) {
        const int item = tid + NTHREADS * i, key = item >> 3, ch = item & 7;
        if (item < 160 * 8) {
            u32x4 kv = {0u, 0u, 0u, 0u}, vv = {0u, 0u, 0u, 0u};
            const size_t o = (((size_t)(l * DBATCH + n) * 128 + (key - 8)) * 2 + kvh) * 64 + ch * 8;
            if (key < 128) {
                const f32x4 k0 = *(const f32x4*)(ck + (size_t)key * 128 + ch * 8), k1 = *(const f32x4*)(ck + (size_t)key * 128 + ch * 8 + 4);
                const f32x4 v0 = *(const f32x4*)(cv + (size_t)key * 128 + ch * 8), v1 = *(const f32x4*)(cv + (size_t)key * 128 + ch * 8 + 4);
                kv = (u32x4){pk2(k0[0], k0[1]), pk2(k0[2], k0[3]), pk2(k1[0], k1[1]), pk2(k1[2], k1[3])};
                vv = (u32x4){pk2(v0[0], v0[1]), pk2(v0[2], v0[3]), pk2(v1[0], v1[1]), pk2(v1[2], v1[3])};
                if (key >= 8) { *(f32x4*)(a.out + O_KS + o) = k0; *(f32x4*)(a.out + O_KS + o + 4) = k1; *(f32x4*)(a.out + O_VS + o) = v0; *(f32x4*)(a.out + O_VS + o + 4) = v1; }
            } else if (key < 136) {
                const bf16_t* zr = Z + (size_t)(MP + n * DSEQ + (key - 128)) * ZP + kvh * 64 + ch * 8;
                kv = *(const u32x4*)(zr + ZK); vv = *(const u32x4*)(zr + ZV);
                store8f(a.out + O_KS + o, kv); store8f(a.out + O_VS + o, vv);
            }
            lds_put_kv(lds, key, ch, kv, vv);
        }
    }
    __syncthreads();
    if (wave < 2) {
        const float sink_l2 = a.in[10][l * 8 + shead] * LOG2E;
        attn_qtile<true>(lds, sqf0, sqf1, AO, MP + n * DSEQ + st, shead, st, 0, true, sink_l2, lane);
    }
    __syncthreads();
}

__device__ __forceinline__ void conv_phase(const Args& a, int l, const bf16_t* Z, bf16_t* BZ, int gtid, int nth) {
    const float* cw = a.in[11] + (size_t)l * 3 * CD;
    for (int item = gtid; item < (M / 4) * 64; item += nth) {
        const int row0 = (item >> 6) * 4, c0 = (item & 63) * 8;
        const bool smp = row0 >= MP;
        const int t0 = smp ? ((row0 - MP) & 7) : (row0 & (SEQ - 1));
        const int n = smp ? ((row0 - MP) >> 3) : (row0 >> 11);
        const bf16_t* zr = Z + (size_t)row0 * ZP + c0;
        u32x4 rB[4], rC[6], rU[6];
#pragma unroll
        for (int i = 0; i < 4; ++i) { rB[i] = *(const u32x4*)(zr + (size_t)i * ZP + ZB); rC[i + 2] = *(const u32x4*)(zr + (size_t)i * ZP + ZC); rU[i + 2] = *(const u32x4*)(zr + (size_t)i * ZP + ZU); }
        float up[6][8];
        if (t0 > 0) {
#pragma unroll
            for (int i = 0; i < 2; ++i) { rC[i] = *(const u32x4*)(zr - (size_t)(2 - i) * ZP + ZC); rU[i] = *(const u32x4*)(zr - (size_t)(2 - i) * ZP + ZU); }
#pragma unroll
            for (int i = 0; i < 2; ++i) { float cv[8], uv[8]; unpack8(rC[i], cv); unpack8(rU[i], uv);
#pragma unroll
                for (int e = 0; e < 8; ++e) up[i][e] = cv[e] * uv[e]; }
        } else if (smp) {
#pragma unroll
            for (int i = 0; i < 2; ++i) { const float* sp = a.in[4] + ((size_t)(l * DBATCH + n) * 2 + i) * CD + c0;
#pragma unroll
                for (int e = 0; e < 8; ++e) up[i][e] = sp[e]; }
        } else {
#pragma unroll
            for (int i = 0; i < 2; ++i)
#pragma unroll
                for (int e = 0; e < 8; ++e) up[i][e] = 0.f;
        }
#pragma unroll
        for (int i = 2; i < 6; ++i) { float cv[8], uv[8]; unpack8(rC[i], cv); unpack8(rU[i], uv);
#pragma unroll
            for (int e = 0; e < 8; ++e) up[i][e] = cv[e] * uv[e]; }
        float w0[8], w1[8], w2[8];
#pragma unroll
        for (int e = 0; e < 8; ++e) { w0[e] = cw[c0 + e]; w1[e] = cw[CD + c0 + e]; w2[e] = cw[2 * CD + c0 + e]; }
        const int tl = smp ? DSEQ : SEQ;
#pragma unroll
        for (int i = 0; i < 4; ++i) {
            float bv[8], o[8]; unpack8(rB[i], bv);
#pragma unroll
            for (int e = 0; e < 8; ++e) o[e] = bv[e] * (w0[e] * up[i][e] + w1[e] * up[i + 1][e] + w2[e] * up[i + 2][e]);
            *(u32x4*)(BZ + (size_t)(row0 + i) * CD + c0) = pack8(o);
            if (i >= 2 && t0 + 4 == tl) {
                float* dst = smp ? a.out + O_CS + ((size_t)(l * DBATCH + n) * 2 + (i - 2)) * CD + c0 : a.out + O_CP + ((size_t)(l * NBATCH + n) * 2 + (i - 2)) * CD + c0;
                *(f32x4*)dst = (f32x4){up[i + 2][0], up[i + 2][1], up[i + 2][2], up[i + 2][3]}; *(f32x4*)(dst + 4) = (f32x4){up[i + 2][4], up[i + 2][5], up[i + 2][6], up[i + 2][7]};
            }
        }
    }
}

#define RLX_AGENT __ATOMIC_RELAXED, __HIP_MEMORY_SCOPE_AGENT
#define XB_TMO      128
#define XB_XCNT(j)  (256  + 64 * (j))
#define XB_XSUB(j)  (1280 + 64 * (j))
#define XB_XGEN(j)  (2304 + 64 * (j))
#define XB_TOP      3328
#define XB_TOPGEN   3392
#define XCD_BAR_WORDS 3456
#define XB_SPIN_CAP (1u << 18)

__device__ __forceinline__ unsigned xb_ld(unsigned* p)              { return __hip_atomic_load(p, __ATOMIC_RELAXED, __HIP_MEMORY_SCOPE_AGENT); }
__device__ __forceinline__ unsigned xb_add(unsigned* p, unsigned v) { return __hip_atomic_fetch_add(p, v, __ATOMIC_RELAXED, __HIP_MEMORY_SCOPE_AGENT); }
__device__ __forceinline__ unsigned xb_xcc_id() { return (unsigned)__builtin_amdgcn_s_getreg((3 << 11) | 20) & 0xFu; }
#define XB_SPIN(cond, bar) do { unsigned _sp = 0; while (cond) { __builtin_amdgcn_s_sleep(1); \
    if ((++_sp & 255u) == 0u) { if (xb_ld(&(bar)[XB_TMO])) break; if (_sp > XB_SPIN_CAP) { atomicAdd(&(bar)[XB_TMO], 1u); break; } } } } while (0)

struct XcdBarrier {
    unsigned* bar; unsigned x;
    volatile LAS unsigned* st;
};

__device__ __forceinline__ XcdBarrier xcd_barrier_post(unsigned* bar, volatile LAS unsigned* st) {
    XcdBarrier b; b.bar = bar; b.x = xb_xcc_id(); b.st = st;
    if (threadIdx.x == 0) (void)xb_add(&bar[XB_XCNT(b.x)], 1u);
    return b;
}
__device__ __forceinline__ void xcd_barrier_complete(unsigned* bar, unsigned x, unsigned& nloc, unsigned& nx) {
    const unsigned G = gridDim.x * gridDim.y * gridDim.z;
    unsigned sum, cnt, mine, sp = 0u;
    for (;;) {
        sum = 0u; cnt = 0u; mine = 0u;
#pragma unroll
        for (unsigned j = 0; j < 16; ++j) { const unsigned c = xb_ld(&bar[XB_XCNT(j)]); sum += c; cnt += (c > 0u) ? 1u : 0u; mine = (j == x) ? c : mine; }
        if (sum == G) break;
        __builtin_amdgcn_s_sleep(1);
        if ((++sp & 255u) == 0u) { if (xb_ld(&bar[XB_TMO])) break; if (sp > XB_SPIN_CAP) { atomicAdd(&bar[XB_TMO], 1u); break; } }
    }
    nloc = mine > 0u ? mine : 1u; nx = cnt > 0u ? cnt : 1u;
}

__device__ __forceinline__ void xcd_barrier(const XcdBarrier& b) {
    asm volatile("s_waitcnt vmcnt(0)" ::: "memory");
    __syncthreads();
    if (threadIdx.x == 0) {
        unsigned* bar = b.bar;
        __builtin_amdgcn_s_waitcnt(0);
        unsigned nloc = b.st[0], nx = b.st[1];
        if (nloc == 0u) { xcd_barrier_complete(bar, b.x, nloc, nx); b.st[0] = nloc; b.st[1] = nx; }
        const unsigned old = xb_add(&bar[XB_XSUB(b.x)], 1u);
        const unsigned gen = old / nloc;
        if (old + 1u == (gen + 1u) * nloc) {
            __builtin_amdgcn_fence(__ATOMIC_RELEASE, "agent");
            asm volatile("s_waitcnt vmcnt(0)" ::: "memory");
            const unsigned og = xb_add(&bar[XB_TOP], 1u);
            const unsigned tg = og / nx;
            if (og + 1u == (tg + 1u) * nx) xb_add(&bar[XB_TOPGEN], 1u);
            else XB_SPIN(xb_ld(&bar[XB_TOPGEN]) == tg, bar);
            __builtin_amdgcn_fence(__ATOMIC_ACQUIRE, "agent");
            xb_add(&bar[XB_XGEN(b.x)], 1u);
            asm volatile("s_waitcnt vmcnt(0)" ::: "memory");
        } else {
            XB_SPIN(xb_ld(&bar[XB_XGEN(b.x)]) == gen, bar);
            __builtin_amdgcn_fence(__ATOMIC_ACQUIRE, "agent");
            asm volatile("s_waitcnt vmcnt(0)" ::: "memory");
        }
    }
    __syncthreads();
}
__device__ __forceinline__ Args fresh_args() {
#if defined(__HIP_DEVICE_COMPILE__)
    const CAS unsigned long long* p = (const CAS unsigned long long*)__builtin_amdgcn_kernarg_segment_ptr(); asm volatile("" : "+s"(p));
    Args a;
#pragma unroll
    for (int i = 0; i < 17; ++i) a.in[i] = (const float*)p[i];
    a.out = (float*)p[17]; a.ws = (unsigned char*)p[18];
    return a;
#else
    return Args{};
#endif
}
__global__ void __launch_bounds__(NTHREADS, 2) fwd_megakernel(Args a_unused) {
    extern __shared__ __attribute__((aligned(16))) unsigned char lds_raw[];
    LAS unsigned char* lds = (LAS unsigned char*)lds_raw;
    cg::grid_group grid = cg::this_grid();
    const int G = gridDim.x, bx = blockIdx.x, NGW = G * NWAVES;
#define FRESH() int tid = threadIdx.x; asm volatile("" : "+v"(tid)); const int lane = tid & 63, wave = __builtin_amdgcn_readfirstlane(tid >> 6), gw = bx * NWAVES + wave; (void)lane; (void)gw
#define PTRS() const Args a = fresh_args(); unsigned char* ws = a.ws; \
    float* R = (float*)(ws + WS_R); bf16_t* Wb = (bf16_t*)(ws + WS_W); bf16_t* Z = (bf16_t*)(ws + WS_Z); bf16_t* S1 = (bf16_t*)(ws + WS_S1); bf16_t* S2 = (bf16_t*)(ws + WS_S2); float* Y = a.out + O_Y; bf16_t* YA = (bf16_t*)Y; bf16_t* YB = YA + (size_t)M * DM; \
    (void)R; (void)Wb; (void)Z; (void)S1; (void)S2; (void)Y; (void)YA; (void)YB

    volatile LAS unsigned* bst = (volatile LAS unsigned*)(lds + 131072 + 64);
    { FRESH(); PTRS(); unsigned* barw = (unsigned*)(ws + WS_BAR);
      if (tid < 2) bst[tid] = 0u;
      if (bx == 0) for (int i = tid; i < XCD_BAR_WORDS; i += NTHREADS) __hip_atomic_store(barw + i, 0u, RLX_AGENT);
      for (int rep_ = 0; rep_ < 1 + ((REPMASK >> 6) & 1); ++rep_) convert_weights(a, 0, Wb, lds, gw, NGW, wave, lane);
      for (int rep_ = 0; rep_ < 1 + ((REPMASK >> 7) & 1); ++rep_) rows_prologue(a.in[0], a.in[1], S2, R, gw, NGW, lane); }
    grid.sync();
    XcdBarrier xbar;
    { PTRS(); xbar = xcd_barrier_post((unsigned*)(ws + WS_BAR), bst); }
#define GSYNC() do { XcdBarrier xb_ = xbar; asm volatile("" : "+s"(xb_.bar), "+s"(xb_.x)); xcd_barrier(xb_); } while (0)

#pragma unroll 1
    for (int l = 0; l < DEPTH; ++l) {
        for (int rep_ = 0; rep_ < 1 + ((REPMASK >> 0) & 1); ++rep_) {
            PTRS();
            pg8::Gemm g{l == 0 ? S2 : YB, Wb + W_IN, M, IN_DIM, DM}; pg8::StaticOrder S; S.init(M, IN_DIM, G, bx);
            Epi<1> E{Z, ZP, R, Z, nullptr};
            pg8::gemm_phase<Epi<1>, pg8::StaticOrder, true, true>(lds, g, S, E);
            GSYNC();
        }
        for (int rep_ = 0; rep_ < 1 + ((REPMASK >> 1) & 1); ++rep_) {
            FRESH(); PTRS();
            for (int u = bx; u < NBATCH * 16 * 2; u += G) attn_prompt_unit(a, l, u, Z, S1, lds, tid, wave, lane);
            for (int u = bx; u < DBATCH * 2; u += G) attn_sample_unit(a, l, u, Z, S1, lds, tid, wave, lane);
            conv_phase(a, l, Z, S1 + (size_t)M * ATT, bx * NTHREADS + tid, G * NTHREADS);
            GSYNC();
        }
        for (int rep_ = 0; rep_ < 1 + ((REPMASK >> 2) & 1); ++rep_) {
            PTRS();
            pg8::Gemm g{S1, Wb + W_BR, 2 * M, 2048, 512}; PairOrder S; S.init(G, bx);
            Epi<3> E{S2, DM, R, Z, nullptr};
            pg8::gemm_phase<Epi<3>, PairOrder, true, true>(lds, g, S, E);
            GSYNC();
        }
        for (int rep_ = 0; rep_ < 1 + ((REPMASK >> 3) & 1); ++rep_) {
            PTRS();
            pg8::Gemm g{S2, Wb + W_OUT, M, DM, DM}; SliceOrder S; S.init(G, bx, 32 / NSL, 16);
            Epi<4> E{S1, DM, R, Z, (float*)Z};
            pg8::gemm_phase<Epi<4>, SliceOrder, true, true>(lds, g, S, E);
            GSYNC();
        }
        { FRESH(); PTRS();
          if (l == 0) rows_residual<true, false>(S1, (const float*)Z, a.in[0], a.in[1], nullptr, a.in[6] + l * DM, nullptr, YA, R, 0, M, gw, NGW, lane);
          else        rows_residual<false, false>(S1, (const float*)Z, nullptr, nullptr, YB, a.in[6] + l * DM, nullptr, S2, R, 0, M, gw, NGW, lane); }
        GSYNC();
        for (int rep_ = 0; rep_ < 1 + ((REPMASK >> 4) & 1); ++rep_) {
            PTRS();
            pg8::Gemm g{l == 0 ? YA : S2, Wb + W_UP, M, FF, DM}; pg8::StaticOrder S; S.init(M, FF, G, bx);
            Epi<6> E{Z, FF, R, Z, nullptr};
            pg8::gemm_phase<Epi<6>, pg8::StaticOrder, true, true>(lds, g, S, E);
            GSYNC();
        }
        for (int rep_ = 0; rep_ < 1 + ((REPMASK >> 5) & 1); ++rep_) {
            PTRS();
            pg8::Gemm g{Z, Wb + W_DN, M, DM, FF}; SliceOrder S; S.init(G, bx, 64 / NSL, 64);
            Epi<4> E{S1, DM, R, Z, l == 0 ? (float*)S2 : (float*)YA};
            pg8::gemm_phase<Epi<4>, SliceOrder, true, true>(lds, g, S, E);
            GSYNC();
        }
        if (l + 1 < DEPTH) {
            { FRESH(); PTRS(); rows_residual<false, false>(S1, (const float*)S2, nullptr, nullptr, YA, a.in[8] + l * DM, nullptr, YB, R, 0, M, gw, NGW, lane);
              for (int rep_ = 0; rep_ < 1 + ((REPMASK >> 6) & 1); ++rep_) convert_weights(a, l + 1, Wb, lds, gw, NGW, wave, lane); }
            GSYNC();
        } else {
            { FRESH(); PTRS(); rows_residual<false, true>(S1, (const float*)YA, nullptr, nullptr, S2, a.in[8] + l * DM, Y, nullptr, nullptr, MP, M, gw, NGW, lane); }
            GSYNC();
            { FRESH(); PTRS(); rows_residual<false, true>(S1, nullptr, nullptr, nullptr, S2, a.in[8] + l * DM, Y, nullptr, nullptr, 0, MP, gw, NGW, lane); }
        }
    }
}

extern "C" void kernel_launch(void* const* d_in, const int* in_sizes, int n_in, void* d_out, int out_size, void* d_ws, size_t ws_size, hipStream_t stream) {
    static int grid = 0;
    if (grid == 0) {
        if (n_in != 17 || ws_size < WS_END) { fprintf(stderr, "kernel_launch: unexpected n_in %d / ws_size %zu (need %zu)\n", n_in, ws_size, (size_t)WS_END); grid = -1; return; }
        int dev = 0, cus = 0, per_cu = 0;
        hipGetDevice(&dev);
        hipDeviceGetAttribute(&cus, hipDeviceAttributeMultiprocessorCount, dev);
        if (hipFuncSetAttribute((const void*)fwd_megakernel, hipFuncAttributeMaxDynamicSharedMemorySize, LDS_BYTES) != hipSuccess) fprintf(stderr, "kernel_launch: hipFuncSetAttribute failed\n");
        if (hipOccupancyMaxActiveBlocksPerMultiprocessor(&per_cu, (const void*)fwd_megakernel, NTHREADS, LDS_BYTES) != hipSuccess || per_cu < 1) { fprintf(stderr, "kernel_launch: occupancy query gave %d\n", per_cu); per_cu = 1; }
        (void)hipGetLastError();
        grid = cus * per_cu;
    }
    if (grid < 0) return;
    Args a{};
    for (int i = 0; i < 17; ++i) a.in[i] = (const float*)d_in[i];
    a.out = (float*)d_out; a.ws = (unsigned char*)d_ws;
    void* args[] = {&a};
    hipError_t e = hipLaunchCooperativeKernel((const void*)fwd_megakernel, dim3(grid), dim3(NTHREADS), args, LDS_BYTES, stream);
    if (e != hipSuccess) fprintf(stderr, "cooperative launch failed: %s (grid %d)\n", hipGetErrorString(e), grid);
}
```

```cpp
#include <hip/hip_runtime.h>
#include <hip/hip_cooperative_groups.h>
#include <cstdio>
#include <cstdint>
namespace cg = cooperative_groups;
namespace pg8 {
#define PG8_LAS __attribute__((address_space(3)))
typedef unsigned short bf16_t;
typedef short bf16x8 __attribute__((ext_vector_type(8)));
typedef float f32x4 __attribute__((ext_vector_type(4)));
typedef unsigned u32x4 __attribute__((ext_vector_type(4)));
constexpr int BM = 256, BK = 64, HALF = 128, HTB = HALF * BK * 2  , STAGE_BYTES = 8 * HTB, NXCD = 8, WGM = 8;

__host__ __device__ __forceinline__ int lds_byte(int r, int c) { const int st = (r >> 4) * 2 + (c >> 5), rr = r & 15, cc = c & 31, ob = rr * 64 + cc * 2; return st * 1024 + (ob ^ (((ob >> 9) & 1) << 5)); }
__host__ __device__ __forceinline__ void stage_rc(int b, int& R, int& C) { const int st = b / 1024, sb = b % 1024, swz = sb ^ (((sb >> 9) & 1) << 5); R = (st >> 1) * 16 + swz / 64; C = (st & 1) * 32 + (swz % 64) / 2; }
__host__ __device__ __forceinline__ int perm32(int rho) { const int n = rho >> 4, i = rho & 15; return 8 * (i >> 2) + 4 * n + (i & 3); }

struct Unit { int pm, pn, pa, pb, w, koff, nt; };
struct Gemm { const bf16_t* A; const bf16_t* Bt; int M, N, K; };

struct StaticOrder {
    int nM, nN, nwg, G, c;
    __host__ __device__ __forceinline__ void init(int M, int N, int G_, int c_) { nM = M / BM; nN = N / BM; nwg = nM * nN; G = G_; c = c_; }
    __host__ __device__ __forceinline__ bool next(int i, Unit& u) const {
        const long L = (long)i * G + c; if (L >= nwg) return false;
        int wgid = (int)L; { const int q = nwg / NXCD, r = nwg % NXCD, xcd = wgid % NXCD, off = wgid / NXCD; wgid = (xcd < r ? xcd * (q + 1) : r * (q + 1) + (xcd - r) * q) + off; }
        const int nig = WGM * nN, gid = wgid / nig, fm = gid * WGM, gsz = (nM - fm) < WGM ? (nM - fm) : WGM;
        u.pm = fm + ((wgid % nig) % gsz); u.pn = (wgid % nig) / gsz; u.pa = u.pm; u.pb = u.pn; u.w = 0; u.koff = 0; u.nt = 0; return true;
    }
    __device__ __forceinline__ void a_ready(const Unit&) const {}
    __device__ __forceinline__ void done(const Unit&) const {}
};
__device__ __forceinline__ unsigned cvt_pk_bf16(float lo, float hi) { unsigned r; asm volatile("v_cvt_pk_bf16_f32 %0, %1, %2" : "=v"(r) : "v"(lo), "v"(hi)); return r; }
template <class Epi, class Sched, bool ALIGN_EPI = false, bool SP2 = false>
__device__ __forceinline__ void gemm_phase(PG8_LAS unsigned char* lds, const Gemm g, const Sched& S, const Epi& E) {
    int tid_ = threadIdx.x; asm volatile("" : "+v"(tid_));
    const int tid = tid_, wid = __builtin_amdgcn_readfirstlane(tid >> 6), lane = tid & 63, wr = wid >> 2, wc = wid & 3, fr = lane & 15, fq = lane >> 4;
    const int K = g.K, nt = K / BK;
    unsigned voffA[2], voffB[2];
#pragma unroll
    for (int i = 0; i < 2; ++i) { int R, C; stage_rc(tid * 16 + i * 8192, R, C); const int Rb = Epi::PERM ? ((R & ~31) + perm32(R & 31)) : R;
        voffA[i] = (unsigned)(R * K + C) * 2u; voffB[i] = (unsigned)(Rb * K + C) * 2u; }
    const size_t kstep = (size_t)(BK * 2);
    const size_t hstep = (size_t)HALF * K * 2;
    const size_t tstep = 2 * hstep;
    const unsigned ldsw = (unsigned)wid * 1024u;
    const int aoff = lds_byte(wr * 64 + fr, fq * 8), boff = lds_byte(wc * 32 + fr, fq * 8);
#define PG8_SA(b, h) (((b) * 2 + (h)) * HTB)
#define PG8_SB(b, h) ((4 + (b) * 2 + (h)) * HTB)
#define PG8_STAGE(bufoff, gbase, voff) do { _Pragma("unroll") for (int _i = 0; _i < 2; ++_i) \
        __builtin_amdgcn_global_load_lds((const unsigned*)((const char*)(gbase) + (voff)[_i]), (PG8_LAS unsigned*)(lds + (bufoff) + ldsw + _i * 8192), 16, 0, 0); } while (0)
#define PG8_LDA(dst, b, h) do { _Pragma("unroll") for (int m = 0; m < 4; ++m) _Pragma("unroll") for (int k = 0; k < 2; ++k) dst[m][k] = *(const PG8_LAS bf16x8*)(lds + PG8_SA(b, h) + aoff + m * 2048 + k * 1024); } while (0)
#define PG8_LDB(dst, b, h) do { _Pragma("unroll") for (int n = 0; n < 2; ++n) _Pragma("unroll") for (int k = 0; k < 2; ++k) dst[n][k] = *(const PG8_LAS bf16x8*)(lds + PG8_SB(b, h) + boff + n * 2048 + k * 1024); } while (0)
#define PG8_MMA(ai, bj, At, Bt) do { __builtin_amdgcn_s_setprio(1); _Pragma("unroll") for (int m = 0; m < 4; ++m) _Pragma("unroll") for (int n = 0; n < 2; ++n) _Pragma("unroll") for (int k = 0; k < 2; ++k) \
        acc[ai][bj][m][n] = __builtin_amdgcn_mfma_f32_16x16x32_bf16(Bt[n][k], At[m][k], acc[ai][bj][m][n], 0, 0, 0); __builtin_amdgcn_s_setprio(0); } while (0)
#define PG8_WAIT_V(n) asm volatile("s_waitcnt vmcnt(" #n ")" ::: "memory")
#define PG8_WAIT_L(n) asm volatile("s_waitcnt lgkmcnt(" #n ")" ::: "memory")
#define PG8_BAR __builtin_amdgcn_s_barrier()
#define PG8_SCHED __builtin_amdgcn_sched_barrier(0)
    Unit cur, nxt; int ui = 0;
    if (!S.next(0, cur)) return;
    f32x4 acc[2][2][4][2];
#pragma unroll
    for (int a = 0; a < 2; ++a)
#pragma unroll
        for (int b = 0; b < 2; ++b)
#pragma unroll
            for (int m = 0; m < 4; ++m)
#pragma unroll
                for (int n = 0; n < 2; ++n) acc[a][b][m][n] = (f32x4){0.f, 0.f, 0.f, 0.f};
    bf16x8 At[4][2], B0[2][2], B1[2][2];
    const char* cA = (const char*)g.A + (size_t)cur.pa * tstep + cur.koff; const char* cB = (const char*)g.Bt + (size_t)cur.pb * tstep + cur.koff;
    S.a_ready(cur);
    if constexpr (SP2) {
        PG8_STAGE(PG8_SB(0, 0), cB, voffB); PG8_STAGE(PG8_SB(0, 1), cB + hstep, voffB); PG8_STAGE(PG8_SA(0, 0), cA, voffA); PG8_STAGE(PG8_SA(0, 1), cA + hstep, voffA);
        if (wr == 1) PG8_BAR;
        PG8_WAIT_V(2); PG8_BAR;
        PG8_STAGE(PG8_SB(1, 0), cB + kstep, voffB); PG8_STAGE(PG8_SA(1, 0), cA + kstep, voffA); PG8_STAGE(PG8_SB(1, 1), cB + hstep + kstep, voffB);
        PG8_WAIT_V(6); PG8_BAR;
    } else {
        PG8_STAGE(PG8_SB(0, 0), cB, voffB); PG8_STAGE(PG8_SA(0, 0), cA, voffA); PG8_STAGE(PG8_SB(0, 1), cB + hstep, voffB); PG8_STAGE(PG8_SA(0, 1), cA + hstep, voffA);
        if (wr == 1) PG8_BAR;
        PG8_WAIT_V(4); PG8_BAR;
        PG8_STAGE(PG8_SB(1, 0), cB + kstep, voffB); PG8_STAGE(PG8_SA(1, 0), cA + kstep, voffA); PG8_STAGE(PG8_SB(1, 1), cB + hstep + kstep, voffB);
        PG8_WAIT_V(6); PG8_BAR;
    }
    for (;;) {
        const bool has_next = S.next(ui + 1, nxt);
        const char* nA = has_next ? (const char*)g.A + (size_t)nxt.pa * tstep + nxt.koff : cA; const char* nB = has_next ? (const char*)g.Bt + (size_t)nxt.pb * tstep + nxt.koff : cB;
        const int unt = cur.nt ? cur.nt : nt;
        for (int t = 0; t < unt; t += 2) {
            const bool last = (t == unt - 2);
            const char* a1 = cA + (size_t)(t + 1) * kstep;
            const char* a2 = last ? nA : cA + (size_t)(t + 2) * kstep; const char* b2 = last ? nB : cB + (size_t)(t + 2) * kstep;
            const char* a3 = a2 + kstep; const char* b3 = b2 + kstep;
            if (last && has_next) S.a_ready(nxt);
            if constexpr (SP2) {
            PG8_LDB(B0, 0, 0); PG8_LDB(B1, 0, 1); PG8_SCHED; PG8_LDA(At, 0, 0); PG8_STAGE(PG8_SA(1, 1), a1 + hstep, voffA);
            PG8_WAIT_V(8); PG8_WAIT_L(0); PG8_BAR; PG8_MMA(0, 0, At, B0); PG8_MMA(0, 1, At, B1); PG8_BAR; PG8_SCHED;
            PG8_LDA(At, 0, 1); PG8_STAGE(PG8_SB(0, 0), b2, voffB); PG8_STAGE(PG8_SB(0, 1), b2 + hstep, voffB); PG8_STAGE(PG8_SA(0, 0), a2, voffA);
            PG8_WAIT_V(8); PG8_WAIT_L(0); PG8_BAR; PG8_MMA(1, 0, At, B0); PG8_MMA(1, 1, At, B1); PG8_BAR; PG8_SCHED;
            PG8_LDB(B0, 1, 0); PG8_LDB(B1, 1, 1); PG8_SCHED; PG8_LDA(At, 1, 0); PG8_STAGE(PG8_SA(0, 1), a2 + hstep, voffA);
            PG8_WAIT_V(8); PG8_WAIT_L(0); PG8_BAR; PG8_MMA(0, 0, At, B0); PG8_MMA(0, 1, At, B1); PG8_BAR; PG8_SCHED;
            PG8_LDA(At, 1, 1); PG8_STAGE(PG8_SB(1, 0), b3, voffB); PG8_STAGE(PG8_SB(1, 1), b3 + hstep, voffB); PG8_STAGE(PG8_SA(1, 0), a3, voffA);
            PG8_WAIT_V(8); PG8_WAIT_L(0); PG8_BAR; PG8_MMA(1, 0, At, B0); PG8_MMA(1, 1, At, B1); PG8_BAR; PG8_SCHED;
            } else {
            PG8_LDB(B0, 0, 0); PG8_SCHED; PG8_LDA(At, 0, 0); PG8_STAGE(PG8_SA(1, 1), a1 + hstep, voffA);
            PG8_WAIT_L(8); PG8_BAR; PG8_WAIT_L(0); PG8_MMA(0, 0, At, B0); PG8_BAR; PG8_SCHED;
            PG8_LDB(B1, 0, 1); PG8_STAGE(PG8_SB(0, 0), b2, voffB);
            PG8_BAR; PG8_WAIT_L(0); PG8_MMA(0, 1, At, B1); PG8_BAR;
            PG8_LDA(At, 0, 1); PG8_STAGE(PG8_SA(0, 0), a2, voffA);
            PG8_BAR; PG8_WAIT_L(0); PG8_MMA(1, 0, At, B0); PG8_BAR; PG8_SCHED;
            PG8_STAGE(PG8_SB(0, 1), b2 + hstep, voffB);
            PG8_WAIT_V(6); PG8_BAR; PG8_MMA(1, 1, At, B1); PG8_BAR;
            PG8_LDB(B0, 1, 0); PG8_SCHED; PG8_LDA(At, 1, 0); PG8_STAGE(PG8_SA(0, 1), a2 + hstep, voffA);
            PG8_WAIT_L(8); PG8_BAR; PG8_WAIT_L(0); PG8_MMA(0, 0, At, B0); PG8_BAR; PG8_SCHED;
            PG8_LDB(B1, 1, 1); PG8_STAGE(PG8_SB(1, 0), b3, voffB);
            PG8_BAR; PG8_WAIT_L(0); PG8_MMA(0, 1, At, B1); PG8_BAR;
            PG8_LDA(At, 1, 1); PG8_STAGE(PG8_SA(1, 0), a3, voffA);
            PG8_BAR; PG8_WAIT_L(0); PG8_MMA(1, 0, At, B0); PG8_BAR; PG8_SCHED;
            PG8_STAGE(PG8_SB(1, 1), b3 + hstep, voffB);
            PG8_WAIT_V(6); PG8_BAR; PG8_MMA(1, 1, At, B1); PG8_BAR;
            }
        }
        if constexpr (ALIGN_EPI) { if (wr == 0) PG8_BAR; }
        if constexpr (!Epi::AFTER_DRAIN) { E(acc, cur, wr, wc, fr, fq); S.done(cur); }
        if (!has_next) break;
#pragma unroll
        for (int a = 0; a < 2; ++a)
#pragma unroll
            for (int b = 0; b < 2; ++b)
#pragma unroll
                for (int m = 0; m < 4; ++m)
#pragma unroll
                    for (int n = 0; n < 2; ++n) acc[a][b][m][n] = (f32x4){0.f, 0.f, 0.f, 0.f};
        cur = nxt; cA = nA; cB = nB; ++ui;
        if constexpr (ALIGN_EPI) { if (wr == 1) PG8_BAR; }
    }
    PG8_WAIT_V(0);
    if constexpr (!ALIGN_EPI) { if (wr == 0) PG8_BAR; }
    PG8_BAR;
    if constexpr (Epi::AFTER_DRAIN) { E.fused(acc, cur, wr, wc, fr, fq, lds, wid, lane); S.done(cur); }
#undef PG8_SA
#undef PG8_SB
#undef PG8_STAGE
#undef PG8_LDA
#undef PG8_LDB
#undef PG8_MMA
#undef PG8_WAIT_V
#undef PG8_WAIT_L
#undef PG8_BAR
#undef PG8_SCHED
}
}
#ifndef REPMASK
#define REPMASK 0
#endif
#define LAS __attribute__((address_space(3)))
#define CAS __attribute__((address_space(4)))
typedef unsigned short bf16_t;
typedef short bf16x8 __attribute__((ext_vector_type(8)));
typedef float f32x4 __attribute__((ext_vector_type(4)));
typedef unsigned u32x4 __attribute__((ext_vector_type(4)));
typedef unsigned u32x2 __attribute__((ext_vector_type(2)));

constexpr int DM = 1024, NBATCH = 8, SEQ = 2048, DEPTH = 2, DBATCH = 128, DSEQ = 8;
constexpr int MP = NBATCH * SEQ, MS = DBATCH * DSEQ, M = MP + MS;
constexpr int IN_DIM = 4352, ATT = 512, CD = 512, FF = 4096;
constexpr int ZP = IN_DIM;
constexpr int ZQ = 0, ZK = 512, ZV = 640, ZB = 768, ZC = 1280, ZU = 1792, ZGA = 2304;
constexpr float EPS = 1e-6f;
constexpr float LOG2E = 1.4426950408889634f;

constexpr size_t O_Y = 0;
constexpr size_t O_KP = (size_t)M * DM;
constexpr size_t O_VP = O_KP + 2 * 8 * 128 * 128;
constexpr size_t O_CP = O_VP + 2 * 8 * 128 * 128;
constexpr size_t O_KS = O_CP + 2 * 8 * 2 * 512;
constexpr size_t O_VS = O_KS + (size_t)2 * 128 * 128 * 128;
constexpr size_t O_CS = O_VS + (size_t)2 * 128 * 128 * 128;

constexpr size_t MiB = 1u << 20;
constexpr size_t WS_R = 0;
constexpr size_t WS_BAR = 512 * 1024;
constexpr size_t WS_W = 3 * MiB;
constexpr size_t W_IN = 0, W_BR = W_IN + (size_t)IN_DIM * DM, W_OUT = W_BR + (size_t)2048 * 512, W_UP = W_OUT + (size_t)DM * DM, W_DN = W_UP + (size_t)FF * DM, W_END = W_DN + (size_t)DM * FF;
constexpr size_t WS_Z = 32 * MiB;
constexpr size_t WS_S1 = 177 * MiB;
constexpr size_t WS_S2 = 211 * MiB;
constexpr size_t WS_END = 247 * MiB;
constexpr int NSL = 8;
static_assert(WS_W + W_END * 2 <= WS_Z && WS_Z + (size_t)M * ZP * 2 <= WS_S1 && WS_S1 + (size_t)M * DM * 2 <= WS_S2 && WS_S2 + (size_t)(M + 1024) * DM * 2 <= WS_END, "ws map");

constexpr int LDS_BYTES = 147456;
constexpr int NTHREADS = 512, NWAVES = 8;

__device__ __forceinline__ float bf2f(unsigned b) { return __uint_as_float(b << 16); }
typedef float f32x2_t __attribute__((ext_vector_type(2))); typedef __bf16 bf16x2_t __attribute__((ext_vector_type(2)));
__device__ __forceinline__ unsigned pk2(float lo, float hi) { const f32x2_t v = {lo, hi}; const bf16x2_t b = __builtin_convertvector(v, bf16x2_t); return __builtin_bit_cast(unsigned, b); }
__device__ __forceinline__ float wave_sum(float v) {
#pragma unroll
    for (int o = 1; o < 64; o <<= 1) v += __shfl_xor(v, o);
    return v;
}
__device__ __forceinline__ void unpack8(const u32x4 v, float (&f)[8]) {
    f[0] = bf2f(v.x & 0xffffu); f[1] = __uint_as_float(v.x & 0xffff0000u); f[2] = bf2f(v.y & 0xffffu); f[3] = __uint_as_float(v.y & 0xffff0000u);
    f[4] = bf2f(v.z & 0xffffu); f[5] = __uint_as_float(v.z & 0xffff0000u); f[6] = bf2f(v.w & 0xffffu); f[7] = __uint_as_float(v.w & 0xffff0000u);
}
__device__ __forceinline__ u32x4 pack8(const float (&f)[8]) { u32x4 w; w.x = pk2(f[0], f[1]); w.y = pk2(f[2], f[3]); w.z = pk2(f[4], f[5]); w.w = pk2(f[6], f[7]); return w; }
__device__ __forceinline__ float sigmoidf_fast(float x) { return __builtin_amdgcn_rcpf(1.0f + __builtin_amdgcn_exp2f(-x * LOG2E)); }

template <int MODE> struct Epi {
    static constexpr bool PERM = true, AFTER_DRAIN = false;
    bf16_t* O; int ldc; const float* r; const bf16_t* Z; float* part;
    __device__ __forceinline__ void operator()(const f32x4 (&acc)[2][2][4][2], const pg8::Unit& u, int wr, int wc, int fr, int fq) const {
        const int row0 = u.pm * 256 + wr * 64 + fr, col0 = u.pn * 256 + wc * 32 + 8 * fq;
        const bool smp = u.pm >= MP / 256;
        float rs[2][4];
        if (MODE == 1 || MODE == 6) {
#pragma unroll
            for (int ai = 0; ai < 2; ++ai)
#pragma unroll
                for (int m = 0; m < 4; ++m) rs[ai][m] = r[row0 + ai * 128 + m * 16];
        }
#pragma unroll
        for (int ai = 0; ai < 2; ++ai) {
            u32x4 gt[4][2], tv[4][2];
            if (MODE == 3) {
#pragma unroll
                for (int m = 0; m < 4; ++m)
#pragma unroll
                    for (int bj = 0; bj < 2; ++bj) gt[m][bj] = *(const u32x4*)(Z + (size_t)(row0 + ai * 128 + m * 16) * ZP + ZGA + u.w * 1024 + col0 + bj * 128);
                if (u.w == 1 && !smp) {
#pragma unroll
                    for (int m = 0; m < 4; ++m)
#pragma unroll
                        for (int bj = 0; bj < 2; ++bj) tv[m][bj] = *(const u32x4*)(O + (size_t)(row0 + ai * 128 + m * 16) * ldc + col0 + bj * 128);
                }
            }
#pragma unroll
            for (int m = 0; m < 4; ++m) {
                const int row = row0 + ai * 128 + m * 16;
#pragma unroll
                for (int bj = 0; bj < 2; ++bj) {
                    const int col = col0 + bj * 128;
                    const f32x4 a0 = acc[ai][bj][m][0], a1 = acc[ai][bj][m][1];
                    if (MODE == 4 && smp) {
                        float* pd = part + ((size_t)u.w * MS + (row - MP)) * DM + col;
                        *(f32x4*)pd = a0; *(f32x4*)(pd + 4) = a1; continue; }
                    bf16_t* dst = O + (size_t)(row + ((MODE == 3 && smp) ? u.w * MS : 0)) * ldc + col;
                    float v[8] = {a0[0], a0[1], a0[2], a0[3], a1[0], a1[1], a1[2], a1[3]};
                    if (MODE == 1) {
#pragma unroll
                        for (int e = 0; e < 8; ++e) v[e] *= rs[ai][m];
                        if (u.pn >= 9) {
#pragma unroll
                            for (int e = 0; e < 8; ++e) v[e] = sigmoidf_fast(v[e]);
                        }
                    } else if (MODE == 3) {
                        float g8[8]; unpack8(gt[m][bj], g8);
#pragma unroll
                        for (int e = 0; e < 8; ++e) v[e] *= g8[e];
                        if (u.w == 1 && !smp) { float t[8]; unpack8(tv[m][bj], t);
#pragma unroll
                            for (int e = 0; e < 8; ++e) v[e] += t[e]; }
                    } else if (MODE == 6) {
#pragma unroll
                        for (int e = 0; e < 8; ++e) { const float q = fmaxf(v[e] * rs[ai][m], 0.f); v[e] = q * q; }
                    }
                    *(u32x4*)dst = pack8(v);
                }
            }
        }
    }
};

struct PairOrder {
    pg8::StaticOrder so; int c;
    __device__ __forceinline__ void init(int G_, int c_) { so.init(MP, DM, G_, c_); c = c_; }
    __device__ __forceinline__ bool next(int i, pg8::Unit& u) const {
        const int np = (so.nwg - c + so.G - 1) / so.G;
        pg8::Unit t; t.pm = 0; t.pn = 0; t.pa = 0; t.pb = 0; t.w = 0; t.koff = 0; t.nt = 0;
        bool ok;
        if (i < 2 * np) { ok = so.next(i >> 1, t); t.w = i & 1; }
        else { const int j = (i - 2 * np) * so.G + c; ok = j < 32; t.pm = MP / 256 + ((j >> 3) & 3); t.pn = (j >> 1) & 3; t.w = j & 1; }
        t.koff = 0; t.nt = 0; t.pa = t.w * (M / 256) + t.pm; t.pb = t.w * 4 + t.pn; u = t; return ok; }
    __device__ __forceinline__ void a_ready(const pg8::Unit&) const {}
    __device__ __forceinline__ void done(const pg8::Unit&) const {}
};
struct SliceOrder {
    pg8::StaticOrder so; int c, ntl, wrapk;
    __device__ __forceinline__ void init(int G_, int c_, int ntl_, int wrapk_) { so.init(MP, DM, G_, c_); c = c_; ntl = ntl_; wrapk = wrapk_; }
    __device__ __forceinline__ bool next(int i, pg8::Unit& u) const {
        const int nsl = (c < 16 * NSL) ? (16 * NSL - c + so.G - 1) / so.G : 0;
        pg8::Unit t; t.pm = 0; t.pn = 0; t.pa = 0; t.pb = 0; t.w = 0; t.koff = 0; t.nt = 0;
        bool ok;
        if (i < nsl) { const int j = i * so.G + c, tile = j / NSL, s = j % NSL, kt0 = s * ntl, src = kt0 / wrapk; ok = true;
            t.pm = MP / 256 + (tile >> 2); t.pn = tile & 3; t.w = s; t.pa = MP / 256 + src * 4 + (tile >> 2); t.pb = t.pn; t.koff = (kt0 % wrapk) * 128; t.nt = ntl; }
        else ok = so.next(i - nsl, t);
        u = t; return ok; }
    __device__ __forceinline__ void a_ready(const pg8::Unit&) const {}
    __device__ __forceinline__ void done(const pg8::Unit&) const {}
};

__device__ __forceinline__ void transpose_item(const float* W, const float* gk, int K, int N, bf16_t* WT, int row_off, LAS float* scr, int item, int lane) {
    const int nblk = N / 32, kb = item / nblk, nb = item % nblk, k0 = 64 * kb, n0 = 32 * nb;
    float wv[32];
#pragma unroll
    for (int i = 0; i < 32; ++i) { const int kk = 2 * i + (lane >> 5); wv[i] = W[(size_t)(k0 + kk) * N + n0 + (lane & 31)]; }
    if (gk) {
#pragma unroll
        for (int i = 0; i < 32; ++i) wv[i] *= gk[k0 + 2 * i + (lane >> 5)];
    }
#pragma unroll
    for (int i = 0; i < 32; ++i) { const int kk = 2 * i + (lane >> 5); scr[kk * 33 + (lane & 31)] = wv[i]; }
    asm volatile("s_waitcnt lgkmcnt(0)" ::: "memory");
    const int c = lane & 7;
#pragma unroll
    for (int j = 0; j < 4; ++j) { const int n = (lane >> 3) + 8 * j; const LAS float* s = scr + (8 * c) * 33 + n;
        u32x4 o; o.x = pk2(s[0 * 33], s[1 * 33]); o.y = pk2(s[2 * 33], s[3 * 33]); o.z = pk2(s[4 * 33], s[5 * 33]); o.w = pk2(s[6 * 33], s[7 * 33]);
        *(u32x4*)(WT + (size_t)(row_off + n0 + n) * K + k0 + 8 * c) = o; }
    asm volatile("s_waitcnt lgkmcnt(0)" ::: "memory");
}
struct Args { const float* in[17]; float* out; unsigned char* ws; };

__device__ __forceinline__ void convert_weights(const Args& a, int l, bf16_t* Wb, LAS unsigned char* lds, int gw, int NGW, int wave, int lane) {
    LAS float* scr = (LAS float*)(lds + wave * 16384);
    constexpr int I_IN = 16 * 136, I_AO = 8 * 32, I_CO = 8 * 32, I_OUT = 16 * 32, I_UP = 16 * 128, I_DN = 64 * 32;
    constexpr int NITEMS = I_IN + I_AO + I_CO + I_OUT + I_UP + I_DN;
    const float* w_in = a.in[9] + (size_t)l * DM * IN_DIM; const float* w_ao = a.in[12] + (size_t)l * ATT * DM; const float* w_co = a.in[13] + (size_t)l * CD * DM;
    const float* w_out = a.in[14] + (size_t)l * DM * DM; const float* w_up = a.in[15] + (size_t)l * DM * FF; const float* w_dn = a.in[16] + (size_t)l * FF * DM;
    const float* g_pre = a.in[5] + l * DM; const float* g_mlp = a.in[7] + l * DM;
    for (int it = gw; it < NITEMS; it += NGW) {
        int r = it;
        if (r < I_IN) { transpose_item(w_in, g_pre, DM, IN_DIM, Wb + W_IN, 0, scr, r, lane); continue; } r -= I_IN;
        if (r < I_AO) { transpose_item(w_ao, nullptr, ATT, DM, Wb + W_BR, 0, scr, r, lane); continue; } r -= I_AO;
        if (r < I_CO) { transpose_item(w_co, nullptr, CD, DM, Wb + W_BR, 1024, scr, r, lane); continue; } r -= I_CO;
        if (r < I_OUT) { transpose_item(w_out, nullptr, DM, DM, Wb + W_OUT, 0, scr, r, lane); continue; } r -= I_OUT;
        if (r < I_UP) { transpose_item(w_up, g_mlp, DM, FF, Wb + W_UP, 0, scr, r, lane); continue; } r -= I_UP;
        transpose_item(w_dn, nullptr, FF, DM, Wb + W_DN, 0, scr, r, lane);
    }
}

__device__ __forceinline__ void rows_prologue(const float* xp, const float* xs, bf16_t* xb, float* r, int gw, int NGW, int lane) {
    for (int row0 = gw; row0 < M; row0 += 4 * NGW) {
        f32x4 v[4][4];
#pragma unroll
        for (int b = 0; b < 4; ++b) { const int row = row0 + b * NGW;
            if (row < M) { const float* xr = (row < MP) ? xp + (size_t)row * DM : xs + (size_t)(row - MP) * DM;
#pragma unroll
                for (int j = 0; j < 4; ++j) v[b][j] = *(const f32x4*)(xr + 4 * lane + 256 * j); } }
#pragma unroll
        for (int b = 0; b < 4; ++b) { const int row = row0 + b * NGW;
            if (row < M) { float ss = 0.f;
#pragma unroll
                for (int j = 0; j < 4; ++j) ss += (v[b][j][0] * v[b][j][0] + v[b][j][1] * v[b][j][1]) + (v[b][j][2] * v[b][j][2] + v[b][j][3] * v[b][j][3]);
                ss = wave_sum(ss);
#pragma unroll
                for (int j = 0; j < 4; ++j) { u32x2 w; w.x = pk2(v[b][j][0], v[b][j][1]); w.y = pk2(v[b][j][2], v[b][j][3]); *(u32x2*)(xb + (size_t)row * DM + 4 * lane + 256 * j) = w; }
                if (lane == 0) r[row] = 1.0f / sqrtf(ss * (1.0f / DM) + EPS); } }
    }
}
constexpr int RB = 4;
template <bool XF32, bool WY>
__device__ __forceinline__ void rows_residual(const bf16_t* src, const float* part, const float* xin_p, const float* xin_s, const bf16_t* xin_b, const float* g, float* yout, bf16_t* xb, float* r, int rb, int re, int gw, int NGW, int lane) {
    f32x4 gv[4];
#pragma unroll
    for (int j = 0; j < 4; ++j) gv[j] = *(const f32x4*)(g + 4 * lane + 256 * j);
    for (int row0 = rb + gw; row0 < re; row0 += RB * NGW) {
        f32x4 s[RB][4], x[RB][4];
#pragma unroll
        for (int b = 0; b < RB; ++b) {
            const int row = row0 + b * NGW;
            if (row < re) {
#pragma unroll
                for (int j = 0; j < 4; ++j) {
                    if (XF32) { const float* xr = (row < MP) ? xin_p + (size_t)row * DM : xin_s + (size_t)(row - MP) * DM; x[b][j] = *(const f32x4*)(xr + 4 * lane + 256 * j); }
                    else { const u32x2 w = *(const u32x2*)(xin_b + (size_t)row * DM + 4 * lane + 256 * j);
                        x[b][j][0] = bf2f(w.x & 0xffffu); x[b][j][1] = __uint_as_float(w.x & 0xffff0000u); x[b][j][2] = bf2f(w.y & 0xffffu); x[b][j][3] = __uint_as_float(w.y & 0xffff0000u); }
                    if (row < MP) { const u32x2 w = *(const u32x2*)(src + (size_t)row * DM + 4 * lane + 256 * j);
                        s[b][j][0] = bf2f(w.x & 0xffffu); s[b][j][1] = __uint_as_float(w.x & 0xffff0000u); s[b][j][2] = bf2f(w.y & 0xffffu); s[b][j][3] = __uint_as_float(w.y & 0xffff0000u); }
                    else { const float* pp = part + (size_t)(row - MP) * DM + 4 * lane + 256 * j; s[b][j] = *(const f32x4*)pp;
#pragma unroll
                        for (int q = 1; q < NSL; ++q) s[b][j] += *(const f32x4*)(pp + (size_t)q * MS * DM); } }
            }
        }
#pragma unroll
        for (int b = 0; b < RB; ++b) {
            const int row = row0 + b * NGW;
            if (row < re) {
                float ss = 0.f;
#pragma unroll
                for (int j = 0; j < 4; ++j) ss += (s[b][j][0] * s[b][j][0] + s[b][j][1] * s[b][j][1]) + (s[b][j][2] * s[b][j][2] + s[b][j][3] * s[b][j][3]);
                ss = wave_sum(ss);
                const float rm = 1.0f / sqrtf(ss * (1.0f / DM) + EPS);
#pragma unroll
                for (int j = 0; j < 4; ++j) x[b][j] = x[b][j] + s[b][j] * rm * gv[j];
                if (WY) {
#pragma unroll
                    for (int j = 0; j < 4; ++j) *(f32x4*)(yout + (size_t)row * DM + 4 * lane + 256 * j) = x[b][j];
                } else {
                    float s2 = 0.f;
#pragma unroll
                    for (int j = 0; j < 4; ++j) { u32x2 w; w.x = pk2(x[b][j][0], x[b][j][1]); w.y = pk2(x[b][j][2], x[b][j][3]); *(u32x2*)(xb + (size_t)row * DM + 4 * lane + 256 * j) = w;
                        const float q0 = bf2f(w.x & 0xffffu), q1 = __uint_as_float(w.x & 0xffff0000u), q2 = bf2f(w.y & 0xffffu), q3 = __uint_as_float(w.y & 0xffff0000u);
                        s2 += (q0 * q0 + q1 * q1) + (q2 * q2 + q3 * q3); }
                    s2 = wave_sum(s2);
                    if (lane == 0) r[row] = 1.0f / sqrtf(s2 * (1.0f / DM) + EPS);
                }
            }
        }
    }
}

constexpr int KS_STRIDE = 72, VT_STRIDE = 264;
constexpr int VT_OFF = 256 * KS_STRIDE * 2;
constexpr float SC_L2 = 0.125f * LOG2E;

template <bool SAMPLE>
__device__ __forceinline__ void attn_qtile(const LAS unsigned char* lds, const bf16x8 qf0, const bf16x8 qf1, bf16_t* AO, int qrow, int head, int iq, int tb, bool has_prev, float sink_l2, int lane) {
    const int q = lane & 15, g = lane >> 4;
    f32x4 s[10];
    const LAS unsigned char* kbase = lds + ((tb * 16 + q) * KS_STRIDE + 8 * g) * 2;
    const int lo1 = (!SAMPLE && !has_prev && iq < 127) ? 128 : iq + 1;
    const unsigned span = (unsigned)(iq + 128 - lo1);
    const int d0 = tb * 16 + 4 * g - lo1;
    float mx = sink_l2;
#pragma unroll
    for (int t = 0; t < 10; ++t) {
        const bf16x8 a0 = *(const LAS bf16x8*)(kbase + t * 16 * KS_STRIDE * 2);
        const bf16x8 a1 = *(const LAS bf16x8*)(kbase + t * 16 * KS_STRIDE * 2 + 64);
        f32x4 z = {0.f, 0.f, 0.f, 0.f};
        z = __builtin_amdgcn_mfma_f32_16x16x32_bf16(a0, qf0, z, 0, 0, 0);
        z = __builtin_amdgcn_mfma_f32_16x16x32_bf16(a1, qf1, z, 0, 0, 0);
#pragma unroll
        for (int j = 0; j < 4; ++j) {
            const bool vis = (unsigned)(d0 + t * 16 + j) <= span;
            const float v = vis ? z[j] * SC_L2 : -INFINITY;
            z[j] = v; mx = fmaxf(mx, v);
        }
        s[t] = z;
    }
    mx = fmaxf(mx, __shfl_xor(mx, 16)); mx = fmaxf(mx, __shfl_xor(mx, 32));
    float sum = 0.f;
#pragma unroll
    for (int t = 0; t < 10; ++t)
#pragma unroll
        for (int j = 0; j < 4; ++j) { const float p = __builtin_amdgcn_exp2f(s[t][j] - mx); s[t][j] = p; sum += p; }
    sum += __shfl_xor(sum, 16); sum += __shfl_xor(sum, 32);
    sum += __builtin_amdgcn_exp2f(sink_l2 - mx);
    const float inv = 1.0f / sum;
    bf16x8 pf[5];
#pragma unroll
    for (int c = 0; c < 5; ++c) {
        u32x4 w; w.x = pk2(s[2 * c][0] * inv, s[2 * c][1] * inv); w.y = pk2(s[2 * c][2] * inv, s[2 * c][3] * inv);
        w.z = pk2(s[2 * c + 1][0] * inv, s[2 * c + 1][1] * inv); w.w = pk2(s[2 * c + 1][2] * inv, s[2 * c + 1][3] * inv);
        pf[c] = __builtin_bit_cast(bf16x8, w);
    }
    f32x4 o[4];
#pragma unroll
    for (int dt = 0; dt < 4; ++dt) o[dt] = (f32x4){0.f, 0.f, 0.f, 0.f};
    const LAS unsigned char* vbase = lds + VT_OFF + (q * VT_STRIDE + tb * 16 + 4 * g) * 2;
#pragma unroll
    for (int c = 0; c < 5; ++c)
#pragma unroll
        for (int dt = 0; dt < 4; ++dt) {
            const u32x2 lo = *(const LAS u32x2*)(vbase + dt * 16 * VT_STRIDE * 2 + c * 64);
            const u32x2 hi = *(const LAS u32x2*)(vbase + dt * 16 * VT_STRIDE * 2 + c * 64 + 32);
            const u32x4 av = {lo.x, lo.y, hi.x, hi.y};
            o[dt] = __builtin_amdgcn_mfma_f32_16x16x32_bf16(__builtin_bit_cast(bf16x8, av), pf[c], o[dt], 0, 0, 0);
        }
#pragma unroll
    for (int dt = 0; dt < 4; ++dt) { u32x2 w; w.x = pk2(o[dt][0], o[dt][1]); w.y = pk2(o[dt][2], o[dt][3]);
        *(u32x2*)(AO + (size_t)qrow * ATT + head * 64 + dt * 16 + 4 * g) = w; }
}

__device__ __forceinline__ void lds_put_kv(LAS unsigned char* lds, int key, int ch, u32x4 kv, u32x4 vv) {
    *(LAS u32x4*)(lds + key * (KS_STRIDE * 2) + ch * 16) = kv;
    LAS unsigned short* vt = (LAS unsigned short*)(lds + VT_OFF) + (ch * 8) * VT_STRIDE + key;
    vt[0 * VT_STRIDE] = (unsigned short)(vv.x & 0xffffu); vt[1 * VT_STRIDE] = (unsigned short)(vv.x >> 16);
    vt[2 * VT_STRIDE] = (unsigned short)(vv.y & 0xffffu); vt[3 * VT_STRIDE] = (unsigned short)(vv.y >> 16);
    vt[4 * VT_STRIDE] = (unsigned short)(vv.z & 0xffffu); vt[5 * VT_STRIDE] = (unsigned short)(vv.z >> 16);
    vt[6 * VT_STRIDE] = (unsigned short)(vv.w & 0xffffu); vt[7 * VT_STRIDE] = (unsigned short)(vv.w >> 16);
}
__device__ __forceinline__ void store8f(float* dst, const u32x4 v) { float f[8]; unpack8(v, f); *(f32x4*)dst = (f32x4){f[0], f[1], f[2], f[3]}; *(f32x4*)(dst + 4) = (f32x4){f[4], f[5], f[6], f[7]}; }

__device__ __forceinline__ void attn_prompt_unit(const Args& a, int l, int unit, const bf16_t* Z, bf16_t* AO, LAS unsigned char* lds, int tid, int wave, int lane) {
    const int b = unit >> 5, qb = (unit >> 1) & 15, kvh = unit & 1;
    const int rowbase = b * SEQ + qb * 128;
    const bool has_prev = qb > 0;
    const int hh = wave >> 1, half = wave & 1, head = kvh * 4 + hh;
    bf16x8 qf[4][2];
#pragma unroll
    for (int qt = 0; qt < 4; ++qt) { const bf16_t* qp = Z + (size_t)(rowbase + half * 64 + qt * 16 + (lane & 15)) * ZP + ZQ + head * 64 + 8 * (lane >> 4);
        qf[qt][0] = *(const bf16x8*)qp; qf[qt][1] = *(const bf16x8*)(qp + 32); }
#pragma unroll
    for (int i = 0; i < 4; ++i) {
        const int item = tid + NTHREADS * i, key = item >> 3, ch = item & 7;
        u32x4 kv = {0u, 0u, 0u, 0u}, vv = {0u, 0u, 0u, 0u};
        if (has_prev || key >= 128) {
            const bf16_t* zr = Z + (size_t)(rowbase - 128 + key) * ZP + kvh * 64 + ch * 8;
            kv = *(const u32x4*)(zr + ZK); vv = *(const u32x4*)(zr + ZV);
            if (qb == 15 && key >= 128) {
                const size_t o = (((size_t)(l * NBATCH + b) * 128 + (key - 128)) * 2 + kvh) * 64 + ch * 8;
                store8f(a.out + O_KP + o, kv); store8f(a.out + O_VP + o, vv);
            }
        }
        lds_put_kv(lds, key, ch, kv, vv);
    }
    __syncthreads();
    const float sink_l2 = a.in[10][l * 8 + head] * LOG2E;
#pragma unroll
    for (int qt = 0; qt < 4; ++qt) {
        const int iq0 = half * 64 + qt * 16, iq = iq0 + (lane & 15);
        attn_qtile<false>(lds, qf[qt][0], qf[qt][1], AO, rowbase + iq, head, iq, (iq0 >> 4) & ~1, has_prev, sink_l2, lane);
    }
    __syncthreads();
}
__device__ __forceinline__ void attn_sample_unit(const Args& a, int l, int unit, const bf16_t* Z, bf16_t* AO, LAS unsigned char* lds, int tid, int wave, int lane) {
    const int n = unit >> 1, kvh = unit & 1;
    const float* ck = a.in[2] + ((size_t)(l * DBATCH + n) * 128) * 128 + kvh * 64;
    const float* cv = a.in[3] + ((size_t)(l * DBATCH + n) * 128) * 128 + kvh * 64;
    const int sq = lane & 15, shead = kvh * 4 + (wave & 1) * 2 + (sq >> 3), st = sq & 7;
    const bf16_t* sqp = Z + (size_t)(MP + n * DSEQ + st) * ZP + ZQ + shead * 64 + 8 * (lane >> 4);
    const bf16x8 sqf0 = *(const bf16x8*)sqp, sqf1 = *(const bf16x8*)(sqp + 32);
#pragma unroll
    for (int i = 0; i < 3; ++i) {
        const int item = tid + NTHREADS * i, key = item >> 3, ch = item & 7;
        if (item < 160 * 8) {
            u32x4 kv = {0u, 0u, 0u, 0u}, vv = {0u, 0u, 0u, 0u};
            const size_t o = (((size_t)(l * DBATCH + n) * 128 + (key - 8)) * 2 + kvh) * 64 + ch * 8;
            if (key < 128) {
                const f32x4 k0 = *(const f32x4*)(ck + (size_t)key * 128 + ch * 8), k1 = *(const f32x4*)(ck + (size_t)key * 128 + ch * 8 + 4);
                const f32x4 v0 = *(const f32x4*)(cv + (size_t)key * 128 + ch * 8), v1 = *(const f32x4*)(cv + (size_t)key * 128 + ch * 8 + 4);
                kv = (u32x4){pk2(k0[0], k0[1]), pk2(k0[2], k0[3]), pk2(k1[0], k1[1]), pk2(k1[2], k1[3])};
                vv = (u32x4){pk2(v0[0], v0[1]), pk2(v0[2], v0[3]), pk2(v1[0], v1[1]), pk2(v1[2], v1[3])};
                if (key >= 8) { *(f32x4*)(a.out + O_KS + o) = k0; *(f32x4*)(a.out + O_KS + o + 4) = k1; *(f32x4*)(a.out + O_VS + o) = v0; *(f32x4*)(a.out + O_VS + o + 4) = v1; }
            } else if (key < 136) {
                const bf16_t* zr = Z + (size_t)(MP + n * DSEQ + (key - 128)) * ZP + kvh * 64 + ch * 8;
                kv = *(const u32x4*)(zr + ZK); vv = *(const u32x4*)(zr + ZV);
                store8f(a.out + O_KS + o, kv); store8f(a.out + O_VS + o, vv);
            }
            lds_put_kv(lds, key, ch, kv, vv);
        }
    }
    __syncthreads();
    if (wave < 2) {
        const float sink_l2 = a.in[10][l * 8 + shead] * LOG2E;
        attn_qtile<true>(lds, sqf0, sqf1, AO, MP + n * DSEQ + st, shead, st, 0, true, sink_l2, lane);
    }
    __syncthreads();
}

__device__ __forceinline__ void conv_phase(const Args& a, int l, const bf16_t* Z, bf16_t* BZ, int gtid, int nth) {
    const float* cw = a.in[11] + (size_t)l * 3 * CD;
    for (int item = gtid; item < (M / 4) * 64; item += nth) {
        const int row0 = (item >> 6) * 4, c0 = (item & 63) * 8;
        const bool smp = row0 >= MP;
        const int t0 = smp ? ((row0 - MP) & 7) : (row0 & (SEQ - 1));
        const int n = smp ? ((row0 - MP) >> 3) : (row0 >> 11);
        const bf16_t* zr = Z + (size_t)row0 * ZP + c0;
        u32x4 rB[4], rC[6], rU[6];
#pragma unroll
        for (int i = 0; i < 4; ++i) { rB[i] = *(const u32x4*)(zr + (size_t)i * ZP + ZB); rC[i + 2] = *(const u32x4*)(zr + (size_t)i * ZP + ZC); rU[i + 2] = *(const u32x4*)(zr + (size_t)i * ZP + ZU); }
        float up[6][8];
        if (t0 > 0) {
#pragma unroll
            for (int i = 0; i < 2; ++i) { rC[i] = *(const u32x4*)(zr - (size_t)(2 - i) * ZP + ZC); rU[i] = *(const u32x4*)(zr - (size_t)(2 - i) * ZP + ZU); }
#pragma unroll
            for (int i = 0; i < 2; ++i) { float cv[8], uv[8]; unpack8(rC[i], cv); unpack8(rU[i], uv);
#pragma unroll
                for (int e = 0; e < 8; ++e) up[i][e] = cv[e] * uv[e]; }
        } else if (smp) {
#pragma unroll
            for (int i = 0; i < 2; ++i) { const float* sp = a.in[4] + ((size_t)(l * DBATCH + n) * 2 + i) * CD + c0;
#pragma unroll
                for (int e = 0; e < 8; ++e) up[i][e] = sp[e]; }
        } else {
#pragma unroll
            for (int i = 0; i < 2; ++i)
#pragma unroll
                for (int e = 0; e < 8; ++e) up[i][e] = 0.f;
        }
#pragma unroll
        for (int i = 2; i < 6; ++i) { float cv[8], uv[8]; unpack8(rC[i], cv); unpack8(rU[i], uv);
#pragma unroll
            for (int e = 0; e < 8; ++e) up[i][e] = cv[e] * uv[e]; }
        float w0[8], w1[8], w2[8];
#pragma unroll
        for (int e = 0; e < 8; ++e) { w0[e] = cw[c0 + e]; w1[e] = cw[CD + c0 + e]; w2[e] = cw[2 * CD + c0 + e]; }
        const int tl = smp ? DSEQ : SEQ;
#pragma unroll
        for (int i = 0; i < 4; ++i) {
            float bv[8], o[8]; unpack8(rB[i], bv);
#pragma unroll
            for (int e = 0; e < 8; ++e) o[e] = bv[e] * (w0[e] * up[i][e] + w1[e] * up[i + 1][e] + w2[e] * up[i + 2][e]);
            *(u32x4*)(BZ + (size_t)(row0 + i) * CD + c0) = pack8(o);
            if (i >= 2 && t0 + 4 == tl) {
                float* dst = smp ? a.out + O_CS + ((size_t)(l * DBATCH + n) * 2 + (i - 2)) * CD + c0 : a.out + O_CP + ((size_t)(l * NBATCH + n) * 2 + (i - 2)) * CD + c0;
                *(f32x4*)dst = (f32x4){up[i + 2][0], up[i + 2][1], up[i + 2][2], up[i + 2][3]}; *(f32x4*)(dst + 4) = (f32x4){up[i + 2][4], up[i + 2][5], up[i + 2][6], up[i + 2][7]};
            }
        }
    }
}

#define RLX_AGENT __ATOMIC_RELAXED, __HIP_MEMORY_SCOPE_AGENT
#define XB_TMO      128
#define XB_XCNT(j)  (256  + 64 * (j))
#define XB_XSUB(j)  (1280 + 64 * (j))
#define XB_XGEN(j)  (2304 + 64 * (j))
#define XB_TOP      3328
#define XB_TOPGEN   3392
#define XCD_BAR_WORDS 3456
#define XB_SPIN_CAP (1u << 18)

__device__ __forceinline__ unsigned xb_ld(unsigned* p)              { return __hip_atomic_load(p, __ATOMIC_RELAXED, __HIP_MEMORY_SCOPE_AGENT); }
__device__ __forceinline__ unsigned xb_add(unsigned* p, unsigned v) { return __hip_atomic_fetch_add(p, v, __ATOMIC_RELAXED, __HIP_MEMORY_SCOPE_AGENT); }
__device__ __forceinline__ unsigned xb_xcc_id() { return (unsigned)__builtin_amdgcn_s_getreg((3 << 11) | 20) & 0xFu; }
#define XB_SPIN(cond, bar) do { unsigned _sp = 0; while (cond) { __builtin_amdgcn_s_sleep(1); \
    if ((++_sp & 255u) == 0u) { if (xb_ld(&(bar)[XB_TMO])) break; if (_sp > XB_SPIN_CAP) { atomicAdd(&(bar)[XB_TMO], 1u); break; } } } } while (0)

struct XcdBarrier {
    unsigned* bar; unsigned x;
    volatile LAS unsigned* st;
};

__device__ __forceinline__ XcdBarrier xcd_barrier_post(unsigned* bar, volatile LAS unsigned* st) {
    XcdBarrier b; b.bar = bar; b.x = xb_xcc_id(); b.st = st;
    if (threadIdx.x == 0) (void)xb_add(&bar[XB_XCNT(b.x)], 1u);
    return b;
}
__device__ __forceinline__ void xcd_barrier_complete(unsigned* bar, unsigned x, unsigned& nloc, unsigned& nx) {
    const unsigned G = gridDim.x * gridDim.y * gridDim.z;
    unsigned sum, cnt, mine, sp = 0u;
    for (;;) {
        sum = 0u; cnt = 0u; mine = 0u;
#pragma unroll
        for (unsigned j = 0; j < 16; ++j) { const unsigned c = xb_ld(&bar[XB_XCNT(j)]); sum += c; cnt += (c > 0u) ? 1u : 0u; mine = (j == x) ? c : mine; }
        if (sum == G) break;
        __builtin_amdgcn_s_sleep(1);
        if ((++sp & 255u) == 0u) { if (xb_ld(&bar[XB_TMO])) break; if (sp > XB_SPIN_CAP) { atomicAdd(&bar[XB_TMO], 1u); break; } }
    }
    nloc = mine > 0u ? mine : 1u; nx = cnt > 0u ? cnt : 1u;
}

__device__ __forceinline__ void xcd_barrier(const XcdBarrier& b) {
    asm volatile("s_waitcnt vmcnt(0)" ::: "memory");
    __syncthreads();
    if (threadIdx.x == 0) {
        unsigned* bar = b.bar;
        __builtin_amdgcn_s_waitcnt(0);
        unsigned nloc = b.st[0], nx = b.st[1];
        if (nloc == 0u) { xcd_barrier_complete(bar, b.x, nloc, nx); b.st[0] = nloc; b.st[1] = nx; }
        const unsigned old = xb_add(&bar[XB_XSUB(b.x)], 1u);
        const unsigned gen = old / nloc;
        if (old + 1u == (gen + 1u) * nloc) {
            __builtin_amdgcn_fence(__ATOMIC_RELEASE, "agent");
            asm volatile("s_waitcnt vmcnt(0)" ::: "memory");
            const unsigned og = xb_add(&bar[XB_TOP], 1u);
            const unsigned tg = og / nx;
            if (og + 1u == (tg + 1u) * nx) xb_add(&bar[XB_TOPGEN], 1u);
            else XB_SPIN(xb_ld(&bar[XB_TOPGEN]) == tg, bar);
            __builtin_amdgcn_fence(__ATOMIC_ACQUIRE, "agent");
            xb_add(&bar[XB_XGEN(b.x)], 1u);
            asm volatile("s_waitcnt vmcnt(0)" ::: "memory");
        } else {
            XB_SPIN(xb_ld(&bar[XB_XGEN(b.x)]) == gen, bar);
            __builtin_amdgcn_fence(__ATOMIC_ACQUIRE, "agent");
            asm volatile("s_waitcnt vmcnt(0)" ::: "memory");
        }
    }
    __syncthreads();
}
__device__ __forceinline__ Args fresh_args() {
#if defined(__HIP_DEVICE_COMPILE__)
    const CAS unsigned long long* p = (const CAS unsigned long long*)__builtin_amdgcn_kernarg_segment_ptr(); asm volatile("" : "+s"(p));
    Args a;
#pragma unroll
    for (int i = 0; i < 17; ++i) a.in[i] = (const float*)p[i];
    a.out = (float*)p[17]; a.ws = (unsigned char*)p[18];
    return a;
#else
    return Args{};
#endif
}
__global__ void __launch_bounds__(NTHREADS, 2) fwd_megakernel(Args a_unused) {
    extern __shared__ __attribute__((aligned(16))) unsigned char lds_raw[];
    LAS unsigned char* lds = (LAS unsigned char*)lds_raw;
    cg::grid_group grid = cg::this_grid();
    const int G = gridDim.x, bx = blockIdx.x, NGW = G * NWAVES;
#define FRESH() int tid = threadIdx.x; asm volatile("" : "+v"(tid)); const int lane = tid & 63, wave = __builtin_amdgcn_readfirstlane(tid >> 6), gw = bx * NWAVES + wave; (void)lane; (void)gw
#define PTRS() const Args a = fresh_args(); unsigned char* ws = a.ws; \
    float* R = (float*)(ws + WS_R); bf16_t* Wb = (bf16_t*)(ws + WS_W); bf16_t* Z = (bf16_t*)(ws + WS_Z); bf16_t* S1 = (bf16_t*)(ws + WS_S1); bf16_t* S2 = (bf16_t*)(ws + WS_S2); float* Y = a.out + O_Y; bf16_t* YA = (bf16_t*)Y; bf16_t* YB = YA + (size_t)M * DM; \
    (void)R; (void)Wb; (void)Z; (void)S1; (void)S2; (void)Y; (void)YA; (void)YB

    volatile LAS unsigned* bst = (volatile LAS unsigned*)(lds + 131072 + 64);
    { FRESH(); PTRS(); unsigned* barw = (unsigned*)(ws + WS_BAR);
      if (tid < 2) bst[tid] = 0u;
      (void)barw;
      for (int rep_ = 0; rep_ < 1 + ((REPMASK >> 6) & 1); ++rep_) convert_weights(a, 0, Wb, lds, gw, NGW, wave, lane);
      for (int rep_ = 0; rep_ < 1 + ((REPMASK >> 7) & 1); ++rep_) rows_prologue(a.in[0], a.in[1], S2, R, gw, NGW, lane); }
    __syncthreads();
    XcdBarrier xbar;
    { PTRS(); xbar = xcd_barrier_post((unsigned*)(ws + WS_BAR), bst);
      if (a.ws == nullptr) grid.sync(); }
#define GSYNC() do { XcdBarrier xb_ = xbar; asm volatile("" : "+s"(xb_.bar), "+s"(xb_.x)); xcd_barrier(xb_); } while (0)
    GSYNC();

#pragma unroll 1
    for (int l = 0; l < DEPTH; ++l) {
        for (int rep_ = 0; rep_ < 1 + ((REPMASK >> 0) & 1); ++rep_) {
            PTRS();
            pg8::Gemm g{l == 0 ? S2 : YB, Wb + W_IN, M, IN_DIM, DM}; pg8::StaticOrder S; S.init(M, IN_DIM, G, bx);
            Epi<1> E{Z, ZP, R, Z, nullptr};
            pg8::gemm_phase<Epi<1>, pg8::StaticOrder, true, true>(lds, g, S, E);
            GSYNC();
        }
        for (int rep_ = 0; rep_ < 1 + ((REPMASK >> 1) & 1); ++rep_) {
            FRESH(); PTRS();
            for (int u = bx; u < NBATCH * 16 * 2; u += G) attn_prompt_unit(a, l, u, Z, S1, lds, tid, wave, lane);
            for (int u = bx; u < DBATCH * 2; u += G) attn_sample_unit(a, l, u, Z, S1, lds, tid, wave, lane);
            conv_phase(a, l, Z, S1 + (size_t)M * ATT, bx * NTHREADS + tid, G * NTHREADS);
            GSYNC();
        }
        for (int rep_ = 0; rep_ < 1 + ((REPMASK >> 2) & 1); ++rep_) {
            PTRS();
            pg8::Gemm g{S1, Wb + W_BR, 2 * M, 2048, 512}; PairOrder S; S.init(G, bx);
            Epi<3> E{S2, DM, R, Z, nullptr};
            pg8::gemm_phase<Epi<3>, PairOrder, true, true>(lds, g, S, E);
            GSYNC();
        }
        for (int rep_ = 0; rep_ < 1 + ((REPMASK >> 3) & 1); ++rep_) {
            PTRS();
            pg8::Gemm g{S2, Wb + W_OUT, M, DM, DM}; SliceOrder S; S.init(G, bx, 32 / NSL, 16);
            Epi<4> E{S1, DM, R, Z, (float*)Z};
            pg8::gemm_phase<Epi<4>, SliceOrder, true, true>(lds, g, S, E);
            GSYNC();
        }
        { FRESH(); PTRS();
          if (l == 0) rows_residual<true, false>(S1, (const float*)Z, a.in[0], a.in[1], nullptr, a.in[6] + l * DM, nullptr, YA, R, 0, M, gw, NGW, lane);
          else        rows_residual<false, false>(S1, (const float*)Z, nullptr, nullptr, YB, a.in[6] + l * DM, nullptr, S2, R, 0, M, gw, NGW, lane); }
        GSYNC();
        for (int rep_ = 0; rep_ < 1 + ((REPMASK >> 4) & 1); ++rep_) {
            PTRS();
            pg8::Gemm g{l == 0 ? YA : S2, Wb + W_UP, M, FF, DM}; pg8::StaticOrder S; S.init(M, FF, G, bx);
            Epi<6> E{Z, FF, R, Z, nullptr};
            pg8::gemm_phase<Epi<6>, pg8::StaticOrder, true, true>(lds, g, S, E);
            GSYNC();
        }
        for (int rep_ = 0; rep_ < 1 + ((REPMASK >> 5) & 1); ++rep_) {
            PTRS();
            pg8::Gemm g{Z, Wb + W_DN, M, DM, FF}; SliceOrder S; S.init(G, bx, 64 / NSL, 64);
            Epi<4> E{S1, DM, R, Z, l == 0 ? (float*)S2 : (float*)YA};
            pg8::gemm_phase<Epi<4>, SliceOrder, true, true>(lds, g, S, E);
            GSYNC();
        }
        if (l + 1 < DEPTH) {
            { FRESH(); PTRS(); rows_residual<false, false>(S1, (const float*)S2, nullptr, nullptr, YA, a.in[8] + l * DM, nullptr, YB, R, 0, M, gw, NGW, lane);
              for (int rep_ = 0; rep_ < 1 + ((REPMASK >> 6) & 1); ++rep_) convert_weights(a, l + 1, Wb, lds, gw, NGW, wave, lane); }
            GSYNC();
        } else {
            { FRESH(); PTRS(); rows_residual<false, true>(S1, (const float*)YA, nullptr, nullptr, S2, a.in[8] + l * DM, Y, nullptr, nullptr, MP, M, gw, NGW, lane); }
            GSYNC();
            { FRESH(); PTRS(); rows_residual<false, true>(S1, nullptr, nullptr, nullptr, S2, a.in[8] + l * DM, Y, nullptr, nullptr, 0, MP, gw, NGW, lane); }
        }
    }
}

extern "C" void kernel_launch(void* const* d_in, const int* in_sizes, int n_in, void* d_out, int out_size, void* d_ws, size_t ws_size, hipStream_t stream) {
    static int grid = 0;
    if (grid == 0) {
        if (n_in != 17 || ws_size < WS_END) { fprintf(stderr, "kernel_launch: unexpected n_in %d / ws_size %zu (need %zu)\n", n_in, ws_size, (size_t)WS_END); grid = -1; return; }
        int dev = 0, cus = 0, per_cu = 0;
        hipGetDevice(&dev);
        hipDeviceGetAttribute(&cus, hipDeviceAttributeMultiprocessorCount, dev);
        if (hipFuncSetAttribute((const void*)fwd_megakernel, hipFuncAttributeMaxDynamicSharedMemorySize, LDS_BYTES) != hipSuccess) fprintf(stderr, "kernel_launch: hipFuncSetAttribute failed\n");
        if (hipOccupancyMaxActiveBlocksPerMultiprocessor(&per_cu, (const void*)fwd_megakernel, NTHREADS, LDS_BYTES) != hipSuccess || per_cu < 1) { fprintf(stderr, "kernel_launch: occupancy query gave %d\n", per_cu); per_cu = 1; }
        (void)hipGetLastError();
        grid = cus * per_cu;
    }
    if (grid < 0) return;
    if (hipMemsetAsync((char*)d_ws + WS_BAR, 0, XCD_BAR_WORDS * sizeof(unsigned), stream) != hipSuccess) { fprintf(stderr, "kernel_launch: memset of the barrier words failed\n"); return; }
    Args a{};
    for (int i = 0; i < 17; ++i) a.in[i] = (const float*)d_in[i];
    a.out = (float*)d_out; a.ws = (unsigned char*)d_ws;
    void* args[] = {&a};
    hipError_t e = hipLaunchCooperativeKernel((const void*)fwd_megakernel, dim3(grid), dim3(NTHREADS), args, LDS_BYTES, stream);
    if (e != hipSuccess) fprintf(stderr, "cooperative launch failed: %s (grid %d)\n", hipGetErrorString(e), grid);
}
```
